# Optimizing an MI355X kernel written in HIP

```python
import math
import jax, jax.numpy as jnp
from jax import lax
import numpy as np

D_MODEL = 1024
BATCH = 4
SEQ = 8192
DEPTH = 1
DEC_BATCH = 32
DEC_SEQ = 32
PAST_LEN = 2048

CHUNK = 64
Q_BLOCK = 128
PLE_DIM = 256
D_FF = 4 * D_MODEL
EPS = 1e-6
NEG_INF = -1e30

FOX_HEADS = 8
FOX_HEAD_DIM = 64
FOX_WIDTH = FOX_HEADS * FOX_HEAD_DIM
MLA_HEADS = 8
MLA_NOPE_DIM = 64
MLA_ROPE_DIM = 32
MLA_V_DIM = 64
MLA_Q_RANK = 384
MLA_KV_RANK = 256
MLA_WIDTH = MLA_HEADS * MLA_V_DIM
ROPE_BASE = 10000.0
D_MIX = FOX_WIDTH + MLA_WIDTH
IN_SIZES = (FOX_WIDTH, FOX_WIDTH, FOX_WIDTH, FOX_HEADS, MLA_Q_RANK, MLA_KV_RANK, MLA_ROPE_DIM)
D_IN = FOX_WIDTH * 3 + FOX_HEADS + MLA_Q_RANK + MLA_KV_RANK + MLA_ROPE_DIM

kernel_name = 'fox_mla_hybrid_stream_step'

F32 = jnp.float32


def _rmsnorm(x, g):
    xf = x.astype(F32)
    y = xf * lax.rsqrt(jnp.mean(xf * xf, axis=-1, keepdims=True) + EPS)
    return (y * g.astype(F32)).astype(x.dtype)


def _apply_rope(x, pos):
    half = x.shape[-1] // 2
    inv = ROPE_BASE ** (-jnp.arange(half, dtype=F32) / half)
    ang = pos.astype(F32)[:, None] * inv
    ang = ang.reshape(ang.shape[:1] + (1,) * (x.ndim - 3) + (half,))
    cos, sin = jnp.cos(ang), jnp.sin(ang)
    x1 = x[..., :half].astype(F32)
    x2 = x[..., half:].astype(F32)
    return jnp.concatenate([x1 * cos - x2 * sin, x1 * sin + x2 * cos], axis=-1).astype(x.dtype)


def _project(xn, pos, lw):
    B, S, _ = xn.shape
    offs = []
    acc = 0
    for n in IN_SIZES[:-1]:
        acc += n
        offs.append(acc)
    z = xn @ lw['w_in']
    fq, fk, fv, ff, mq, mkv, mkr = jnp.split(z, offs, axis=-1)
    fox_q = fq.reshape(B, S, FOX_HEADS, FOX_HEAD_DIM)
    fox_k = fk.reshape(B, S, FOX_HEADS, FOX_HEAD_DIM)
    fox_v = fv.reshape(B, S, FOX_HEADS, FOX_HEAD_DIM)
    fox_logf = jax.nn.log_sigmoid((ff + lw['b_fox_f']).astype(F32))
    q = (_rmsnorm(mq, lw['g_mla_q']) @ lw['w_mla_q_up']).reshape(B, S, MLA_HEADS, MLA_NOPE_DIM + MLA_ROPE_DIM)
    q_nope = q[..., :MLA_NOPE_DIM]
    q_pe = _apply_rope(q[..., MLA_NOPE_DIM:], pos)
    ckv = _rmsnorm(mkv, lw['g_mla_kv'])
    kpe = _apply_rope(mkr, pos)
    return fox_q, fox_k, fox_v, fox_logf, q_nope, q_pe, ckv, kpe


def _fox_prompt(q, k, v, logf):
    B, S, H, D = q.shape
    scale = 1.0 / math.sqrt(D)
    c = jnp.cumsum(logf, axis=1)
    cT = c.transpose(0, 2, 1)
    nb = S // Q_BLOCK
    qb = q.reshape(B, nb, Q_BLOCK, H, D).transpose(1, 0, 2, 3, 4)
    cb = c.reshape(B, nb, Q_BLOCK, H).transpose(1, 0, 2, 3)
    kpos = jnp.arange(S)

    def one(args):
        i, qi, ci = args
        s = jnp.einsum('bqhd,bkhd->bhqk', qi, k, preferred_element_type=F32) * scale
        s = s + ci.transpose(0, 2, 1)[..., None] - cT[:, :, None, :]
        qpos = i * Q_BLOCK + jnp.arange(Q_BLOCK)
        s = jnp.where(kpos[None, :] <= qpos[:, None], s, NEG_INF)
        p = jax.nn.softmax(s, axis=-1)
        return jnp.einsum('bhqk,bkhd->bqhd', p.astype(v.dtype), v)

    o = lax.map(one, (jnp.arange(nb), qb, cb))
    return o.transpose(1, 0, 2, 3, 4).reshape(B, S, H, D)


def _fox_sample(q, k, v, logf, cache_k, cache_v, cache_logf):
    B, T, H, D = q.shape
    P = cache_k.shape[1]
    scale = 1.0 / math.sqrt(D)
    k_all = jnp.concatenate([cache_k, k], axis=1)
    v_all = jnp.concatenate([cache_v, v], axis=1)
    c = jnp.cumsum(jnp.concatenate([cache_logf.astype(F32), logf], axis=1), axis=1)
    cT = c.transpose(0, 2, 1)
    s = jnp.einsum('bqhd,bkhd->bhqk', q, k_all, preferred_element_type=F32) * scale
    s = s + cT[:, :, P:, None] - cT[:, :, None, :]
    kpos = jnp.arange(P + T)
    qpos = P + jnp.arange(T)
    s = jnp.where(kpos[None, :] <= qpos[:, None], s, NEG_INF)
    p = jax.nn.softmax(s, axis=-1)
    return jnp.einsum('bhqk,bkhd->bqhd', p.astype(v_all.dtype), v_all)


def _mla_prompt(q_nope, q_pe, ckv, kpe, w_kv_up):
    B, S, H, _ = q_nope.shape
    scale = 1.0 / math.sqrt(MLA_NOPE_DIM + MLA_ROPE_DIM)
    kv = (ckv @ w_kv_up).reshape(B, S, H, MLA_NOPE_DIM + MLA_V_DIM)
    k_nope = kv[..., :MLA_NOPE_DIM]
    v = kv[..., MLA_NOPE_DIM:]
    nb = S // Q_BLOCK
    qnb = q_nope.reshape(B, nb, Q_BLOCK, H, MLA_NOPE_DIM).transpose(1, 0, 2, 3, 4)
    qpb = q_pe.reshape(B, nb, Q_BLOCK, H, MLA_ROPE_DIM).transpose(1, 0, 2, 3, 4)
    kchunk = jnp.arange(S) // CHUNK

    def one(args):
        i, qn, qp = args
        s = (jnp.einsum('bqhn,bkhn->bhqk', qn, k_nope, preferred_element_type=F32)
             + jnp.einsum('bqhr,bkr->bhqk', qp, kpe, preferred_element_type=F32)) * scale
        qchunk = (i * Q_BLOCK + jnp.arange(Q_BLOCK)) // CHUNK
        s = jnp.where(kchunk[None, :] <= qchunk[:, None], s, NEG_INF)
        p = jax.nn.softmax(s, axis=-1)
        return jnp.einsum('bhqk,bkhv->bqhv', p.astype(v.dtype), v)

    o = lax.map(one, (jnp.arange(nb), qnb, qpb))
    return o.transpose(1, 0, 2, 3, 4).reshape(B, S, H, MLA_V_DIM)


def _mla_sample(q_nope, q_pe, ckv, kpe, cache_ckv, cache_kpe, w_kv_up):
    scale = 1.0 / math.sqrt(MLA_NOPE_DIM + MLA_ROPE_DIM)
    ckv_all = jnp.concatenate([cache_ckv, ckv], axis=1)
    kpe_all = jnp.concatenate([cache_kpe, kpe], axis=1)
    w_kv = w_kv_up.reshape(MLA_KV_RANK, MLA_HEADS, MLA_NOPE_DIM + MLA_V_DIM)
    w_uk = w_kv[..., :MLA_NOPE_DIM]
    w_uv = w_kv[..., MLA_NOPE_DIM:]
    q_lat = jnp.einsum('bqhn,chn->bqhc', q_nope, w_uk)
    s = (jnp.einsum('bqhc,bkc->bhqk', q_lat, ckv_all, preferred_element_type=F32)
         + jnp.einsum('bqhr,bkr->bhqk', q_pe, kpe_all, preferred_element_type=F32)) * scale
    p = jax.nn.softmax(s, axis=-1)
    o_lat = jnp.einsum('bhqk,bkc->bqhc', p.astype(ckv_all.dtype), ckv_all)
    return jnp.einsum('bqhc,chv->bqhv', o_lat, w_uv)


def _layer(h, p_l, pos, lw, cache):
    B, S, _ = h.shape
    xn = _rmsnorm(h, lw['g_pre_mix'])
    fq, fk, fv, flogf, q_nope, q_pe, ckv, kpe = _project(xn, pos, lw)
    if cache is None:
        o_fox = _fox_prompt(fq, fk, fv, flogf)
        o_mla = _mla_prompt(q_nope, q_pe, ckv, kpe, lw['w_mla_kv_up'])
    else:
        c_k, c_v, c_logf, c_ckv, c_kpe = cache
        o_fox = _fox_sample(fq, fk, fv, flogf, c_k, c_v, c_logf)
        o_mla = _mla_sample(q_nope, q_pe, ckv, kpe, c_ckv, c_kpe, lw['w_mla_kv_up'])
    of = _rmsnorm(o_fox.reshape(B, S, FOX_WIDTH), lw['g_fox_out'])
    om = _rmsnorm(o_mla.reshape(B, S, MLA_WIDTH), lw['g_mla_out'])
    mix = jnp.concatenate([of, om], axis=-1) @ lw['w_out']
    h = h + _rmsnorm(mix, lw['g_post_mix'])
    u = _rmsnorm(h, lw['g_pre_mlp']) @ lw['w_up']
    h = h + _rmsnorm(jnp.square(jax.nn.relu(u)) @ lw['w_down'], lw['g_post_mlp'])
    gate = jax.nn.sigmoid(_rmsnorm(h, lw['g_ple']) @ lw['w_ple_gate'])
    h = h + _rmsnorm((p_l @ lw['w_ple_proj']) * gate, lw['g_ple_post'])
    return h, (fk, fv, flogf, ckv, kpe)


def setup_inputs(seed: int = 0) -> dict:
    key = jax.random.key(seed)
    ks = jax.random.split(key, 32)
    nrm = lambda k, shape, s: jax.random.normal(k, shape, F32) * s
    gain = lambda k, n: 1.0 + 0.05 * jax.random.normal(k, (DEPTH, n), F32)
    return {
        'x_prompt': nrm(ks[0], (BATCH, SEQ, D_MODEL), 1.0),
        'x_sample': nrm(ks[1], (DEC_BATCH, DEC_SEQ, D_MODEL), 1.0),
        'p_prompt': nrm(ks[2], (DEPTH, BATCH, SEQ, PLE_DIM), 1.0),
        'p_sample': nrm(ks[3], (DEPTH, DEC_BATCH, DEC_SEQ, PLE_DIM), 1.0),
        'cache_fox_k': nrm(ks[4], (DEPTH, DEC_BATCH, PAST_LEN, FOX_HEADS, FOX_HEAD_DIM), 1.0),
        'cache_fox_v': nrm(ks[5], (DEPTH, DEC_BATCH, PAST_LEN, FOX_HEADS, FOX_HEAD_DIM), 1.0),
        'cache_fox_logf': jax.nn.log_sigmoid(2.0 + jax.random.normal(ks[6], (DEPTH, DEC_BATCH, PAST_LEN, FOX_HEADS), F32)),
        'cache_mla_ckv': nrm(ks[7], (DEPTH, DEC_BATCH, PAST_LEN, MLA_KV_RANK), 1.0),
        'cache_mla_kpe': nrm(ks[8], (DEPTH, DEC_BATCH, PAST_LEN, MLA_ROPE_DIM), 1.0),
        'g_pre_mix': gain(ks[9], D_MODEL),
        'w_in': nrm(ks[10], (DEPTH, D_MODEL, D_IN), D_MODEL ** -0.5),
        'b_fox_f': 2.0 + 0.5 * jax.random.normal(ks[11], (DEPTH, FOX_HEADS), F32),
        'g_mla_q': gain(ks[12], MLA_Q_RANK),
        'w_mla_q_up': nrm(ks[13], (DEPTH, MLA_Q_RANK, MLA_HEADS * (MLA_NOPE_DIM + MLA_ROPE_DIM)), MLA_Q_RANK ** -0.5),
        'g_mla_kv': gain(ks[14], MLA_KV_RANK),
        'w_mla_kv_up': nrm(ks[15], (DEPTH, MLA_KV_RANK, MLA_HEADS * (MLA_NOPE_DIM + MLA_V_DIM)), MLA_KV_RANK ** -0.5),
        'g_fox_out': gain(ks[16], FOX_WIDTH),
        'g_mla_out': gain(ks[17], MLA_WIDTH),
        'w_out': nrm(ks[18], (DEPTH, D_MIX, D_MODEL), D_MIX ** -0.5),
        'g_post_mix': gain(ks[19], D_MODEL),
        'g_pre_mlp': gain(ks[20], D_MODEL),
        'w_up': nrm(ks[21], (DEPTH, D_MODEL, D_FF), D_MODEL ** -0.5),
        'w_down': nrm(ks[22], (DEPTH, D_FF, D_MODEL), D_FF ** -0.5),
        'g_post_mlp': gain(ks[23], D_MODEL),
        'g_ple': gain(ks[24], D_MODEL),
        'w_ple_gate': nrm(ks[25], (DEPTH, D_MODEL, D_MODEL), D_MODEL ** -0.5),
        'w_ple_proj': nrm(ks[26], (DEPTH, PLE_DIM, D_MODEL), PLE_DIM ** -0.5),
        'g_ple_post': gain(ks[27], D_MODEL),
    }


def reference(x_prompt, x_sample, p_prompt, p_sample, cache_fox_k, cache_fox_v, cache_fox_logf,
              cache_mla_ckv, cache_mla_kpe, g_pre_mix, w_in, b_fox_f, g_mla_q, w_mla_q_up, g_mla_kv,
              w_mla_kv_up, g_fox_out, g_mla_out, w_out, g_post_mix, g_pre_mlp, w_up, w_down, g_post_mlp,
              g_ple, w_ple_gate, w_ple_proj, g_ple_post):
    pos_prompt = jnp.arange(x_prompt.shape[1])
    pos_sample = cache_fox_k.shape[2] + jnp.arange(x_sample.shape[1])
    hp, hs = x_prompt, x_sample
    st_p, st_s = [], []
    for l in range(DEPTH):
        lw = dict(g_pre_mix=g_pre_mix[l], w_in=w_in[l], b_fox_f=b_fox_f[l], g_mla_q=g_mla_q[l],
                  w_mla_q_up=w_mla_q_up[l], g_mla_kv=g_mla_kv[l], w_mla_kv_up=w_mla_kv_up[l],
                  g_fox_out=g_fox_out[l], g_mla_out=g_mla_out[l], w_out=w_out[l],
                  g_post_mix=g_post_mix[l], g_pre_mlp=g_pre_mlp[l], w_up=w_up[l], w_down=w_down[l],
                  g_post_mlp=g_post_mlp[l], g_ple=g_ple[l], w_ple_gate=w_ple_gate[l],
                  w_ple_proj=w_ple_proj[l], g_ple_post=g_ple_post[l])
        hp, sp = _layer(hp, p_prompt[l], pos_prompt, lw, None)
        hs, ss = _layer(hs, p_sample[l], pos_sample, lw,
                        (cache_fox_k[l], cache_fox_v[l], cache_fox_logf[l], cache_mla_ckv[l], cache_mla_kpe[l]))
        st_p.append(sp)
        st_s.append(ss)
    stk = lambda lst, j: jnp.stack([e[j] for e in lst], axis=0)
    return (hp, hs,
            stk(st_p, 0), stk(st_p, 1), stk(st_p, 2), stk(st_p, 3), stk(st_p, 4),
            stk(st_s, 0), stk(st_s, 1), stk(st_s, 2), stk(st_s, 3), stk(st_s, 4))
```

```cpp
#include <hip/hip_runtime.h>
#include <hip/hip_cooperative_groups.h>
#include <cstdio>
namespace cg = cooperative_groups;

typedef unsigned short u16;
using bf16x8 = __attribute__((ext_vector_type(8))) short;
using f32x16 = __attribute__((ext_vector_type(16))) float;
using u32x4 = __attribute__((ext_vector_type(4))) unsigned;

#define T_P 32768
#define T_ALL 33792
#define U_ALL 99328
#define USL (U_ALL + 64)
#define LOG2E 1.4426950408889634f
#define EPSN 1e-6f

#ifndef COOP
#define COOP 1
#endif

constexpr size_t SZ_WIN = 2304ull * 1024 * 2, SZ_WQ = 768ull * 384 * 2, SZ_WKV = 1024ull * 256 * 2,
                 SZ_WO = 1024ull * 1024 * 2, SZ_WUP = 4096ull * 1024 * 2, SZ_WDN = 1024ull * 4096 * 2,
                 SZ_WG = 1024ull * 1024 * 2, SZ_WPJ = 1024ull * 256 * 2, SZ_ROPE = 8192ull * 16 * 4;
constexpr size_t OFF_WIN = 0, OFF_WQ = OFF_WIN + SZ_WIN, OFF_WKV = OFF_WQ + SZ_WQ, OFF_WO = OFF_WKV + SZ_WKV,
                 OFF_WUP = OFF_WO + SZ_WO, OFF_WDN = OFF_WUP + SZ_WUP, OFF_WG = OFF_WDN + SZ_WDN,
                 OFF_WPJ = OFF_WG + SZ_WG, OFF_COS = OFF_WPJ + SZ_WPJ, OFF_SIN = OFF_COS + SZ_ROPE,
                 OFF_ACT1 = OFF_SIN + SZ_ROPE;
constexpr size_t SZ_ACT1 = (size_t)T_ALL * 1024 * 2;
constexpr size_t OFF_POOL = OFF_ACT1 + SZ_ACT1;
constexpr size_t OFF_QF = OFF_POOL, SZ_QF = (size_t)T_ALL * 512 * 2;
constexpr size_t OFF_KPE = OFF_QF + SZ_QF, SZ_KPE = (size_t)USL * 32 * 2;
constexpr size_t OFF_LOGF = OFF_KPE + SZ_KPE, SZ_LOGF = (size_t)USL * 8 * 4;
constexpr size_t OFF_C2 = OFF_LOGF + SZ_LOGF;
constexpr size_t OFF_KF = OFF_C2 + SZ_LOGF, SZ_KF = (size_t)USL * 512 * 2;
constexpr size_t OFF_VTF = OFF_KF + SZ_KF;
constexpr size_t OFF_KN = OFF_VTF + SZ_KF;
constexpr size_t OFF_ZV = OFF_KN + SZ_KF;
constexpr size_t SZ_ZV = (size_t)T_ALL * 768 * 4;
constexpr size_t OFF_END = OFF_ZV + SZ_ZV;
constexpr size_t OFF_MIX = OFF_POOL;
constexpr size_t OFF_ACT = OFF_POOL;
constexpr size_t OFF_D = OFF_POOL + (size_t)T_ALL * 4096 * 2;
constexpr size_t OFF_PL = OFF_D + (size_t)T_ALL * 1024 * 4;
static_assert(OFF_PL + (size_t)T_ALL * 256 * 2 <= OFF_END, "pool too small");
static_assert((size_t)USL * 512 * 2 <= SZ_ZV, "zv");

constexpr size_t O_Y = 0, O_FKP = 34603008ull, O_FVP = 51380224ull, O_LFP = 68157440ull, O_CKVP = 68419584ull,
                 O_KPEP = 76808192ull, O_FKS = 77856768ull, O_FVS = 78381056ull, O_LFS = 78905344ull,
                 O_CKVS = 78913536ull, O_KPES = 79175680ull;

struct P {
  const float *x_p, *x_s, *p_p, *p_s, *c_fk, *c_fv, *c_lf, *c_ckv, *c_kpe;
  const float *g_pre_mix, *w_in, *b_fox_f, *g_mla_q, *w_q_up, *g_mla_kv, *w_kv_up, *g_fox_out, *g_mla_out, *w_out,
      *g_post_mix, *g_pre_mlp, *w_up, *w_down, *g_post_mlp, *g_ple, *w_gate, *w_proj, *g_ple_post;
  float* out;
  char* ws;
};

__device__ __forceinline__ u16 f2bf(float f) {
  unsigned u = __float_as_uint(f);
  u += 0x7fffu + ((u >> 16) & 1u);
  return (u16)(u >> 16);
}
__device__ __forceinline__ float bf2f(u16 v) { return __uint_as_float(((unsigned)v) << 16); }
__device__ __forceinline__ unsigned pack2(float a, float b) { return (unsigned)f2bf(a) | ((unsigned)f2bf(b) << 16); }
__device__ __forceinline__ float wave_sum(float v) {
#pragma unroll
  for (int o = 32; o > 0; o >>= 1) v += __shfl_xor(v, o);
  return v;
}
__device__ __forceinline__ int urow(int r) {
  return r < T_P ? r : T_P + ((r - T_P) >> 5) * 2080 + 2048 + ((r - T_P) & 31);
}
__device__ __forceinline__ float fast_exp2(float x) { return __builtin_amdgcn_exp2f(x); }

__device__ __forceinline__ int winmap(int c) {
  if (c < 1536) return c;
  if (c < 2208) return c + 8;
  if (c < 2216) return c - 672;
  return -1;
}

__device__ __forceinline__ void transpose_tile(const float* __restrict__ src, int ld_s, u16* __restrict__ dst,
                                               size_t ld_d, int r0, int c0, int mode, float* lds) {
  const int tx = threadIdx.x & 63, ty = threadIdx.x >> 6;
#pragma unroll 4
  for (int i = 0; i < 16; i++) {
    int r = i * 4 + ty;
    int c = c0 + tx;
    int cs = mode ? winmap(c) : c;
    float v = (cs >= 0) ? src[(size_t)(r0 + r) * ld_s + cs] : 0.f;
    lds[r * 65 + tx] = v;
  }
  __syncthreads();
#pragma unroll 4
  for (int i = 0; i < 16; i++) {
    int c = i * 4 + ty;
    dst[(size_t)(c0 + c) * ld_d + r0 + tx] = f2bf(lds[tx * 65 + c]);
  }
  __syncthreads();
}

__device__ void transpose_weight(const float* src, int K, int Nsrc, int Npad, u16* dst, int mode, float* lds) {
  const int nct = Npad / 64, nt = (K / 64) * nct;
  for (int t = blockIdx.x; t < nt; t += gridDim.x) {
    int rt = t / nct, ct = t % nct;
    transpose_tile(src, Nsrc, dst, (size_t)K, rt * 64, ct * 64, mode, lds);
  }
}

__constant__ float ROPE_INV[16] = {1.000000000e+00f, 5.623413324e-01f, 3.162277639e-01f, 1.778279394e-01f,
                                   1.000000015e-01f, 5.623413250e-02f, 3.162277490e-02f, 1.778279431e-02f,
                                   9.999999776e-03f, 5.623413250e-03f, 3.162277630e-03f, 1.778279431e-03f,
                                   1.000000047e-03f, 5.623413017e-04f, 3.162277571e-04f, 1.778279402e-04f};

__device__ void phase0(const P& p, char* smem) {
  char* ws = p.ws;
  float* lds = (float*)smem;
  transpose_weight(p.w_in, 1024, 2216, 2304, (u16*)(ws + OFF_WIN), 1, lds);
  transpose_weight(p.w_q_up, 384, 768, 768, (u16*)(ws + OFF_WQ), 0, lds);
  transpose_weight(p.w_kv_up, 256, 1024, 1024, (u16*)(ws + OFF_WKV), 0, lds);
  transpose_weight(p.w_out, 1024, 1024, 1024, (u16*)(ws + OFF_WO), 0, lds);
  transpose_weight(p.w_up, 1024, 4096, 4096, (u16*)(ws + OFF_WUP), 0, lds);
  transpose_weight(p.w_down, 4096, 1024, 1024, (u16*)(ws + OFF_WDN), 0, lds);
  transpose_weight(p.w_gate, 1024, 1024, 1024, (u16*)(ws + OFF_WG), 0, lds);
  transpose_weight(p.w_proj, 256, 1024, 1024, (u16*)(ws + OFF_WPJ), 0, lds);
  for (int it = blockIdx.x; it < 8192; it += gridDim.x) {
    int b = it >> 8, rt = (it >> 3) & 31, ct = it & 7;
    transpose_tile(p.c_fv + (size_t)b * 2048 * 512, 512, (u16*)(ws + OFF_VTF) + (size_t)(T_P + b * 2080) * 512,
                   (size_t)2080, rt * 64, ct * 64, 0, lds);
  }
  const size_t gtid = (size_t)blockIdx.x * 256 + threadIdx.x, gsz = (size_t)gridDim.x * 256;
  {
    float* cosT = (float*)(ws + OFF_COS);
    float* sinT = (float*)(ws + OFF_SIN);
    for (size_t i = gtid; i < 8192 * 16; i += gsz) {
      int pos = (int)(i >> 4), k = (int)(i & 15);
      float ang = (float)pos * ROPE_INV[k];
      cosT[i] = cosf(ang);
      sinT[i] = sinf(ang);
    }
  }
  {
    u16* Kf = (u16*)(ws + OFF_KF);
    for (size_t c = gtid; c < (size_t)65536 * 64; c += gsz) {
      size_t e = c * 8;
      int row = (int)(e >> 9), col = (int)(e & 511);
      int u = T_P + (row >> 11) * 2080 + (row & 2047);
      float4 a = *(const float4*)(p.c_fk + e), b = *(const float4*)(p.c_fk + e + 4);
      uint4 o = {pack2(a.x, a.y), pack2(a.z, a.w), pack2(b.x, b.y), pack2(b.z, b.w)};
      *(uint4*)(Kf + (size_t)u * 512 + col) = o;
    }
  }
  {
    u16* ckvb = (u16*)((char*)p.out + (size_t)T_ALL * 384 * 2);
    for (size_t c = gtid; c < (size_t)65536 * 32; c += gsz) {
      size_t e = c * 8;
      int row = (int)(e >> 8), col = (int)(e & 255);
      int u = T_P + (row >> 11) * 2080 + (row & 2047);
      float4 a = *(const float4*)(p.c_ckv + e), b = *(const float4*)(p.c_ckv + e + 4);
      uint4 o = {pack2(a.x, a.y), pack2(a.z, a.w), pack2(b.x, b.y), pack2(b.z, b.w)};
      *(uint4*)(ckvb + (size_t)u * 256 + col) = o;
    }
  }
  {
    u16* kpeb = (u16*)(ws + OFF_KPE);
    for (size_t c = gtid; c < (size_t)65536 * 4; c += gsz) {
      size_t e = c * 8;
      int row = (int)(e >> 5), col = (int)(e & 31);
      int u = T_P + (row >> 11) * 2080 + (row & 2047);
      float4 a = *(const float4*)(p.c_kpe + e), b = *(const float4*)(p.c_kpe + e + 4);
      uint4 o = {pack2(a.x, a.y), pack2(a.z, a.w), pack2(b.x, b.y), pack2(b.z, b.w)};
      *(uint4*)(kpeb + (size_t)u * 32 + col) = o;
    }
  }
  {
    float* lw = (float*)(ws + OFF_LOGF);
    for (size_t c = gtid; c < (size_t)65536 * 2; c += gsz) {
      size_t e = c * 4;
      int row = (int)(e >> 3), col = (int)(e & 7);
      int u = T_P + (row >> 11) * 2080 + (row & 2047);
      *(float4*)(lw + (size_t)u * 8 + col) = *(const float4*)(p.c_lf + e);
    }
  }
  {
    const int lane = threadIdx.x & 63, w = threadIdx.x >> 6;
    u16* xn = (u16*)(ws + OFF_ACT1);
    for (int r = blockIdx.x * 4 + w; r < T_ALL; r += gridDim.x * 4) {
      const float* x = r < T_P ? p.x_p + (size_t)r * 1024 : p.x_s + (size_t)(r - T_P) * 1024;
      float4 v[4];
      float ss = 0.f;
#pragma unroll
      for (int i = 0; i < 4; i++) {
        v[i] = *(const float4*)(x + i * 256 + lane * 4);
        ss += v[i].x * v[i].x + v[i].y * v[i].y + v[i].z * v[i].z + v[i].w * v[i].w;
      }
      ss = wave_sum(ss);
      float rs = rsqrtf(ss * (1.f / 1024.f) + EPSN);
#pragma unroll
      for (int i = 0; i < 4; i++) {
        float4 g = *(const float4*)(p.g_pre_mix + i * 256 + lane * 4);
        uint2 o = {pack2(v[i].x * rs * g.x, v[i].y * rs * g.y), pack2(v[i].z * rs * g.z, v[i].w * rs * g.w)};
        *(uint2*)(xn + (size_t)r * 1024 + i * 256 + lane * 4) = o;
      }
    }
  }
}

enum { EPI_IN = 0, EPI_BF16 = 1, EPI_KV = 2, EPI_F32 = 3, EPI_RELU2 = 4, EPI_GATE = 5, EPI_PROD = 6 };

template <int EPI>
__device__ __forceinline__ void gemm_tile(const P& p, const u16* __restrict__ A, int lda,
                                          const u16* __restrict__ Bt, int K, int m0, int n0, void* Cptr, int ldc,
                                          char* smem) {
  u16* sA = (u16*)smem;
  u16* sB = sA + 128 * 72;
  const int tid = threadIdx.x, lane = tid & 63, w = tid >> 6, wm = w >> 1, wn = w & 1;
  const int l31 = lane & 31, hh = lane >> 5;
  f32x16 acc[2][2];
#pragma unroll
  for (int i = 0; i < 2; i++)
#pragma unroll
    for (int j = 0; j < 2; j++)
#pragma unroll
      for (int r = 0; r < 16; r++) acc[i][j][r] = 0.f;

  const int lr = tid >> 3, lc = (tid & 7) * 8;
  const u16* Ap = A + (size_t)(m0 + lr) * lda + lc;
  const u16* Bp = Bt + (size_t)(n0 + lr) * K + lc;
  u32x4 ra[4], rb[4];
#pragma unroll
  for (int i = 0; i < 4; i++) {
    ra[i] = *(const u32x4*)(Ap + (size_t)i * 32 * lda);
    rb[i] = *(const u32x4*)(Bp + (size_t)i * 32 * K);
  }
  const int nk = K >> 6;
  for (int kt = 0; kt < nk; kt++) {
#pragma unroll
    for (int i = 0; i < 4; i++) {
      *(u32x4*)&sA[(lr + i * 32) * 72 + lc] = ra[i];
      *(u32x4*)&sB[(lr + i * 32) * 72 + lc] = rb[i];
    }
    __syncthreads();
    if (kt + 1 < nk) {
#pragma unroll
      for (int i = 0; i < 4; i++) {
        ra[i] = *(const u32x4*)(Ap + (size_t)i * 32 * lda + (kt + 1) * 64);
        rb[i] = *(const u32x4*)(Bp + (size_t)i * 32 * K + (kt + 1) * 64);
      }
    }
#pragma unroll
    for (int ks = 0; ks < 4; ks++) {
      bf16x8 a0 = *(const bf16x8*)&sA[(wm * 64 + l31) * 72 + ks * 16 + hh * 8];
      bf16x8 a1 = *(const bf16x8*)&sA[(wm * 64 + 32 + l31) * 72 + ks * 16 + hh * 8];
      bf16x8 b0 = *(const bf16x8*)&sB[(wn * 64 + l31) * 72 + ks * 16 + hh * 8];
      bf16x8 b1 = *(const bf16x8*)&sB[(wn * 64 + 32 + l31) * 72 + ks * 16 + hh * 8];
      acc[0][0] = __builtin_amdgcn_mfma_f32_32x32x16_bf16(a0, b0, acc[0][0], 0, 0, 0);
      acc[0][1] = __builtin_amdgcn_mfma_f32_32x32x16_bf16(a0, b1, acc[0][1], 0, 0, 0);
      acc[1][0] = __builtin_amdgcn_mfma_f32_32x32x16_bf16(a1, b0, acc[1][0], 0, 0, 0);
      acc[1][1] = __builtin_amdgcn_mfma_f32_32x32x16_bf16(a1, b1, acc[1][1], 0, 0, 0);
    }
    __syncthreads();
  }

  char* ws = p.ws;
#pragma unroll
  for (int mi = 0; mi < 2; mi++)
#pragma unroll
    for (int ni = 0; ni < 2; ni++)
#pragma unroll
      for (int g = 0; g < 4; g++) {
        const int row = m0 + wm * 64 + mi * 32 + 8 * g + 4 * hh;
        const int col = n0 + wn * 64 + ni * 32 + l31;
        float v[4];
#pragma unroll
        for (int j = 0; j < 4; j++) v[j] = acc[mi][ni][4 * g + j];
        if (EPI == EPI_IN) {
          const int nt = n0 >> 7;
          if (nt < 4) {
            u16* Qf = (u16*)(ws + OFF_QF);
#pragma unroll
            for (int j = 0; j < 4; j++) Qf[(size_t)(row + j) * 512 + col] = f2bf(v[j]);
          } else if (nt < 8) {
            const int cc = col - 512;
            u16* Kf = (u16*)(ws + OFF_KF);
            float* o = row < T_P ? p.out + O_FKP + (size_t)row * 512 : p.out + O_FKS + (size_t)(row - T_P) * 512;
            const int u = urow(row);
#pragma unroll
            for (int j = 0; j < 4; j++) {
              o[(size_t)j * 512 + cc] = v[j];
              Kf[(size_t)(u + j) * 512 + cc] = f2bf(v[j]);
            }
          } else if (nt < 12) {
            const int cc = col - 1024;
            float* o = row < T_P ? p.out + O_FVP + (size_t)row * 512 : p.out + O_FVS + (size_t)(row - T_P) * 512;
#pragma unroll
            for (int j = 0; j < 4; j++) o[(size_t)j * 512 + cc] = v[j];
            size_t vbase;
            int pos, len;
            if (row < T_P) {
              vbase = (size_t)(row >> 13) * 8192 * 512; pos = row & 8191; len = 8192;
            } else {
              int rr = row - T_P;
              vbase = (size_t)(T_P + (rr >> 5) * 2080) * 512; pos = 2048 + (rr & 31); len = 2080;
            }
            u16* Vt = (u16*)(ws + OFF_VTF);
            uint2 pk = {pack2(v[0], v[1]), pack2(v[2], v[3])};
            *(uint2*)(Vt + vbase + (size_t)cc * len + pos) = pk;
          } else {
            float* zz = (float*)(ws + OFF_ZV);
#pragma unroll
            for (int j = 0; j < 4; j++) zz[(size_t)(row + j) * 768 + (col - 1536)] = v[j];
          }
        } else if (EPI == EPI_BF16) {
          u16* C = (u16*)Cptr;
#pragma unroll
          for (int j = 0; j < 4; j++) C[(size_t)(row + j) * ldc + col] = f2bf(v[j]);
        } else if (EPI == EPI_KV) {
          const int h = n0 >> 7;
          if (wn == 0) {
            u16* Kn = (u16*)(ws + OFF_KN);
            const int d = col - n0;
#pragma unroll
            for (int j = 0; j < 4; j++) Kn[(size_t)(row + j) * 512 + h * 64 + d] = f2bf(v[j]);
          } else {
            const int d = col - n0 - 64;
            size_t vbase;
            int pos, len;
            if (row < T_P) {
              vbase = (size_t)(row >> 13) * 8192 * 512; pos = row & 8191; len = 8192;
            } else {
              int rr = row - T_P;
              int b = rr / 2080;
              vbase = (size_t)(T_P + b * 2080) * 512; pos = rr - b * 2080; len = 2080;
            }
            u16* Vt = (u16*)(ws + OFF_ZV);
            uint2 pk = {pack2(v[0], v[1]), pack2(v[2], v[3])};
            *(uint2*)(Vt + vbase + (size_t)(h * 64 + d) * len + pos) = pk;
          }
        } else if (EPI == EPI_F32) {
          float* C = (float*)Cptr;
#pragma unroll
          for (int j = 0; j < 4; j++) C[(size_t)(row + j) * ldc + col] = v[j];
        } else if (EPI == EPI_RELU2) {
          u16* C = (u16*)Cptr;
#pragma unroll
          for (int j = 0; j < 4; j++) {
            float t = fmaxf(v[j], 0.f);
            C[(size_t)(row + j) * ldc + col] = f2bf(t * t);
          }
        } else if (EPI == EPI_GATE) {
          float* C = (float*)Cptr;
#pragma unroll
          for (int j = 0; j < 4; j++) C[(size_t)(row + j) * ldc + col] = 1.f / (1.f + __expf(-v[j]));
        } else if (EPI == EPI_PROD) {
          float* C = (float*)Cptr;
#pragma unroll
          for (int j = 0; j < 4; j++) {
            size_t a = (size_t)(row + j) * ldc + col;
            C[a] = C[a] * v[j];
          }
        }
      }
}

__device__ void phase_r2(const P& p) {
  char* ws = p.ws;
  const int lane = threadIdx.x & 63, w = threadIdx.x >> 6;
  const float* zz = (const float*)(ws + OFF_ZV);
  u16* qn = (u16*)p.out;
  u16* ckvb = (u16*)((char*)p.out + (size_t)T_ALL * 384 * 2);
  u16* kpeb = (u16*)(ws + OFF_KPE);
  float* lw = (float*)(ws + OFF_LOGF);
  const float* cosT = (const float*)(ws + OFF_COS);
  const float* sinT = (const float*)(ws + OFF_SIN);
  for (int r = blockIdx.x * 4 + w; r < T_ALL; r += gridDim.x * 4) {
    const float* z = zz + (size_t)r * 768;
    const int u = urow(r);
    const bool pr = r < T_P;
    const int rs_ = r - T_P;
    {
      float4 a = *(const float4*)(z + lane * 4);
      float2 b = *(const float2*)(z + 256 + lane * 2);
      float ss = a.x * a.x + a.y * a.y + a.z * a.z + a.w * a.w + b.x * b.x + b.y * b.y;
      ss = wave_sum(ss);
      float rs = rsqrtf(ss * (1.f / 384.f) + EPSN);
      float4 g = *(const float4*)(p.g_mla_q + lane * 4);
      float2 g2 = *(const float2*)(p.g_mla_q + 256 + lane * 2);
      uint2 o = {pack2(a.x * rs * g.x, a.y * rs * g.y), pack2(a.z * rs * g.z, a.w * rs * g.w)};
      *(uint2*)(qn + (size_t)r * 384 + lane * 4) = o;
      *(unsigned*)(qn + (size_t)r * 384 + 256 + lane * 2) = pack2(b.x * rs * g2.x, b.y * rs * g2.y);
    }
    {
      float4 a = *(const float4*)(z + 384 + lane * 4);
      float ss = a.x * a.x + a.y * a.y + a.z * a.z + a.w * a.w;
      ss = wave_sum(ss);
      float rs = rsqrtf(ss * (1.f / 256.f) + EPSN);
      float4 g = *(const float4*)(p.g_mla_kv + lane * 4);
      float4 o = {a.x * rs * g.x, a.y * rs * g.y, a.z * rs * g.z, a.w * rs * g.w};
      float* oc = pr ? p.out + O_CKVP + (size_t)r * 256 : p.out + O_CKVS + (size_t)rs_ * 256;
      *(float4*)(oc + lane * 4) = o;
      uint2 ob = {pack2(o.x, o.y), pack2(o.z, o.w)};
      *(uint2*)(ckvb + (size_t)u * 256 + lane * 4) = ob;
    }
    if (lane < 16) {
      const int pos = pr ? (r & 8191) : 2048 + (rs_ & 31);
      float x1 = z[640 + lane], x2 = z[656 + lane];
      float c = cosT[pos * 16 + lane], s = sinT[pos * 16 + lane];
      float o1 = x1 * c - x2 * s, o2 = x1 * s + x2 * c;
      float* ok = pr ? p.out + O_KPEP + (size_t)r * 32 : p.out + O_KPES + (size_t)rs_ * 32;
      ok[lane] = o1;
      ok[16 + lane] = o2;
      kpeb[(size_t)u * 32 + lane] = f2bf(o1);
      kpeb[(size_t)u * 32 + 16 + lane] = f2bf(o2);
    }
    if (lane < 8) {
      float x = z[672 + lane] + p.b_fox_f[lane];
      float lf = fminf(x, 0.f) - log1pf(expf(-fabsf(x)));
      float* ol = pr ? p.out + O_LFP + (size_t)r * 8 : p.out + O_LFS + (size_t)rs_ * 8;
      ol[lane] = lf;
      lw[(size_t)u * 8 + lane] = lf;
    }
  }
}

__device__ void scan_seq(const P& p, int seq, char* smem) {
  float* tot = (float*)smem;
  const float* lw = (const float*)(p.ws + OFF_LOGF);
  float* c2 = (float*)(p.ws + OFF_C2);
  const int tid = threadIdx.x, h = tid & 7, sg = tid >> 3;
  const int len = seq < 4 ? 8192 : 2080;
  const int rowbase = seq < 4 ? seq * 8192 : T_P + (seq - 4) * 2080;
  const int sl = len / 32;
  const size_t b0 = ((size_t)rowbase + (size_t)sg * sl) * 8 + h;
  float s = 0.f;
#pragma unroll 8
  for (int i = 0; i < sl; i++) s += lw[b0 + (size_t)i * 8];
  tot[sg * 8 + h] = s;
  __syncthreads();
  float run = 0.f;
  for (int j = 0; j < sg; j++) run += tot[j * 8 + h];
#pragma unroll 8
  for (int i = 0; i < sl; i++) {
    run += lw[b0 + (size_t)i * 8];
    c2[b0 + (size_t)i * 8] = run * LOG2E;
  }
  __syncthreads();
}

template <int DK, bool FOX>
__device__ __forceinline__ void attn_item(const P& p, int seq, int h, int qb, char* smem) {
  constexpr int KS = DK + 8;
  constexpr int VS = 68;
  constexpr int NKS = DK / 16;
  constexpr int NKC = DK / 8;
  constexpr int NKL = (64 * NKC) / 256;
  u16* sK = (u16*)smem;
  u16* sV = sK + 64 * KS;
  float* sC = (float*)(sV + 64 * VS);
  char* ws = p.ws;
  const int tid = threadIdx.x, lane = tid & 63, w = tid >> 6, l31 = lane & 31, hh = lane >> 5;

  const u16* Q = (const u16*)(ws + (FOX ? OFF_QF : OFF_ACT1));
  const int ldq = FOX ? 512 : 768;
  const u16* Kb = (const u16*)(ws + (FOX ? OFF_KF : OFF_KN));
  const u16* kpeb = (const u16*)(ws + OFF_KPE);
  const u16* Vt = (const u16*)(ws + (FOX ? OFF_VTF : OFF_ZV));
  const float* c2 = (const float*)(ws + OFF_C2);
  float* O = p.out + (FOX ? 0 : (size_t)T_ALL * 512);

  const bool prompt = seq < 4;
  const int len = prompt ? 8192 : 2080;
  const int rowbase = prompt ? seq * 8192 : T_P + (seq - 4) * 2080;
  const int qpos0 = prompt ? qb * 128 : 2048;
  const int qtok0 = prompt ? seq * 8192 + qb * 128 : T_P + (seq - 4) * 32;
  const bool wvalid = prompt || w == 0;
  const int wq = wvalid ? w * 32 : 0;
  const int qpos = qpos0 + wq + l31;
  const int qtok = qtok0 + wq + l31;
  int lim, lim_min, lim_max;
  if (FOX) { lim = qpos; lim_min = qpos0 + wq; lim_max = lim_min + 31; }
  else if (prompt) { lim = qpos | 63; lim_min = (qpos0 + wq) | 63; lim_max = lim_min; }
  else { lim = 2079; lim_min = 2079; lim_max = 2079; }
  const int nt_w = wvalid ? (lim_max >> 6) + 1 : 0;
  const int nt_b = prompt ? 2 * qb + 2 : 33;
  const float sc = (FOX ? 0.125f : 0.10206207261596577f) * LOG2E;

  bf16x8 qf[NKS];
  {
    const u16* qp = Q + (size_t)qtok * ldq + h * DK + hh * 8;
#pragma unroll
    for (int ks = 0; ks < NKS; ks++) qf[ks] = *(const bf16x8*)(qp + ks * 16);
    if (!FOX) {
      const float* ct = (const float*)(ws + OFF_COS) + qpos * 16 + hh * 8;
      const float* st = (const float*)(ws + OFF_SIN) + qpos * 16 + hh * 8;
#pragma unroll
      for (int j = 0; j < 8; j++) {
        float x1 = bf2f((u16)qf[NKS - 2][j]), x2 = bf2f((u16)qf[NKS - 1][j]);
        float c = ct[j], s = st[j];
        qf[NKS - 2][j] = (short)f2bf(x1 * c - x2 * s);
        qf[NKS - 1][j] = (short)f2bf(x1 * s + x2 * c);
      }
    }
  }
  float ci = 0.f;
  if (FOX) ci = c2[((size_t)rowbase + qpos) * 8 + h];

  f32x16 oacc[2];
#pragma unroll
  for (int i = 0; i < 2; i++)
#pragma unroll
    for (int r = 0; r < 16; r++) oacc[i][r] = 0.f;
  float m_i = -1e30f, l_i = 0.f;

  uint4 kreg[NKL], vreg[2];
  float creg = 0.f;
  auto load_tile = [&](int t) {
    const int key0 = t * 64;
#pragma unroll
    for (int i = 0; i < NKL; i++) {
      int c = tid + i * 256;
      int key = c / NKC, kc = c % NKC;
      int kk = key0 + key;
      uint4 v = {0, 0, 0, 0};
      if (kk < len) {
        size_t row = (size_t)rowbase + kk;
        if (FOX || kc < 8) v = *(const uint4*)(Kb + row * 512 + h * 64 + kc * 8);
        else v = *(const uint4*)(kpeb + row * 32 + (kc - 8) * 8);
      }
      kreg[i] = v;
    }
#pragma unroll
    for (int i = 0; i < 2; i++) {
      int c = tid + i * 256;
      int d = c >> 3, kc = c & 7;
      uint4 v = {0, 0, 0, 0};
      if (key0 + kc * 8 < len)
        v = *(const uint4*)(Vt + (size_t)rowbase * 512 + (size_t)(h * 64 + d) * len + key0 + kc * 8);
      vreg[i] = v;
    }
    if (FOX) {
      if (tid < 64) {
        int kk = key0 + tid;
        creg = kk < len ? c2[((size_t)rowbase + kk) * 8 + h] : 0.f;
      }
    }
  };
  load_tile(0);

  for (int t = 0; t < nt_b; t++) {
    __syncthreads();
#pragma unroll
    for (int i = 0; i < NKL; i++) {
      int c = tid + i * 256;
      int key = c / NKC, kc = c % NKC;
      *(uint4*)&sK[key * KS + kc * 8] = kreg[i];
    }
#pragma unroll
    for (int i = 0; i < 2; i++) {
      int c = tid + i * 256;
      int d = c >> 3, kc = c & 7;
      uint2 lo = {vreg[i].x, vreg[i].y}, hi = {vreg[i].z, vreg[i].w};
      *(uint2*)&sV[d * VS + kc * 8] = lo;
      *(uint2*)&sV[d * VS + kc * 8 + 4] = hi;
    }
    if (FOX) {
      if (tid < 64) sC[tid] = creg;
    }
    __syncthreads();
    if (t + 1 < nt_b) load_tile(t + 1);
    if (t < nt_w) {
      f32x16 sacc[2];
#pragma unroll
      for (int i = 0; i < 2; i++)
#pragma unroll
        for (int r = 0; r < 16; r++) sacc[i][r] = 0.f;
#pragma unroll
      for (int ks = 0; ks < NKS; ks++) {
#pragma unroll
        for (int mb = 0; mb < 2; mb++) {
          bf16x8 kf = *(const bf16x8*)&sK[(mb * 32 + l31) * KS + ks * 16 + hh * 8];
          sacc[mb] = __builtin_amdgcn_mfma_f32_32x32x16_bf16(kf, qf[ks], sacc[mb], 0, 0, 0);
        }
      }
      const int key0 = t * 64;
      const bool need_mask = (key0 + 63 > lim_min);
      float mx = -1e30f;
#pragma unroll
      for (int mb = 0; mb < 2; mb++)
#pragma unroll
        for (int g = 0; g < 4; g++) {
          float4 cj = {0.f, 0.f, 0.f, 0.f};
          if (FOX) cj = *(const float4*)&sC[mb * 32 + 8 * g + 4 * hh];
          const float cja[4] = {cj.x, cj.y, cj.z, cj.w};
#pragma unroll
          for (int j = 0; j < 4; j++) {
            float v = sacc[mb][4 * g + j] * sc;
            if (FOX) v += ci - cja[j];
            if (need_mask) {
              int key = key0 + mb * 32 + 8 * g + 4 * hh + j;
              if (key > lim) v = -1e30f;
            }
            sacc[mb][4 * g + j] = v;
            mx = fmaxf(mx, v);
          }
        }
      mx = fmaxf(mx, __shfl_xor(mx, 32));
      const float m_new = fmaxf(m_i, mx);
      const float alpha = fast_exp2(m_i - m_new);
      m_i = m_new;
      float ps = 0.f;
#pragma unroll
      for (int mb = 0; mb < 2; mb++)
#pragma unroll
        for (int r = 0; r < 16; r++) {
          float pv = fast_exp2(sacc[mb][r] - m_new);
          sacc[mb][r] = pv;
          ps += pv;
        }
      l_i = l_i * alpha + ps;
#pragma unroll
      for (int db = 0; db < 2; db++)
#pragma unroll
        for (int r = 0; r < 16; r++) oacc[db][r] *= alpha;
#pragma unroll
      for (int mb = 0; mb < 2; mb++)
#pragma unroll
        for (int s = 0; s < 2; s++) {
          union { unsigned u[4]; bf16x8 v; } pf;
#pragma unroll
          for (int j = 0; j < 4; j++) pf.u[j] = pack2(sacc[mb][8 * s + 2 * j], sacc[mb][8 * s + 2 * j + 1]);
#pragma unroll
          for (int db = 0; db < 2; db++) {
            const u16* vp = &sV[(db * 32 + l31) * VS + mb * 32 + s * 16 + 4 * hh];
            uint2 lo = *(const uint2*)vp, hi = *(const uint2*)(vp + 8);
            union { unsigned u[4]; bf16x8 v; } vf;
            vf.u[0] = lo.x; vf.u[1] = lo.y; vf.u[2] = hi.x; vf.u[3] = hi.y;
            oacc[db] = __builtin_amdgcn_mfma_f32_32x32x16_bf16(vf.v, pf.v, oacc[db], 0, 0, 0);
          }
        }
    }
  }
  l_i += __shfl_xor(l_i, 32);
  if (wvalid) {
    const float inv = 1.f / l_i;
    float* op = O + (size_t)qtok * 512 + h * 64;
#pragma unroll
    for (int db = 0; db < 2; db++)
#pragma unroll
      for (int g = 0; g < 4; g++) {
        float4 o = {oacc[db][4 * g] * inv, oacc[db][4 * g + 1] * inv, oacc[db][4 * g + 2] * inv,
                    oacc[db][4 * g + 3] * inv};
        *(float4*)(op + db * 32 + 8 * g + 4 * hh) = o;
      }
  }
  __syncthreads();
}

__device__ void phase_attn(const P& p, char* smem) {
  for (int idx = blockIdx.x; idx < 4608; idx += gridDim.x) {
    int type, seq, h, qb;
    if (idx < 3008) {
      qb = 63 - (idx >> 6);
      int sub = idx & 63;
      type = sub >> 5; seq = (sub >> 3) & 3; h = sub & 7;
    } else if (idx < 3520) {
      int j = idx - 3008;
      type = j >> 8; seq = 4 + ((j >> 3) & 31); h = j & 7; qb = 0;
    } else {
      int j = idx - 3520;
      qb = 16 - (j >> 6);
      int sub = j & 63;
      type = sub >> 5; seq = (sub >> 3) & 3; h = sub & 7;
    }
    if (type == 0) attn_item<96, false>(p, seq, h, qb, smem);
    else attn_item<64, true>(p, seq, h, qb, smem);
  }
}

__device__ void phase_r3(const P& p) {
  const int lane = threadIdx.x & 63, w = threadIdx.x >> 6;
  u16* cat = (u16*)(p.ws + OFF_ACT1);
  for (int r = blockIdx.x * 4 + w; r < T_ALL; r += gridDim.x * 4) {
#pragma unroll
    for (int part = 0; part < 2; part++) {
      const float* o = p.out + (size_t)part * T_ALL * 512 + (size_t)r * 512;
      const float* g = part ? p.g_mla_out : p.g_fox_out;
      float4 a = *(const float4*)(o + lane * 4), b = *(const float4*)(o + 256 + lane * 4);
      float ss = a.x * a.x + a.y * a.y + a.z * a.z + a.w * a.w + b.x * b.x + b.y * b.y + b.z * b.z + b.w * b.w;
      ss = wave_sum(ss);
      float rs = rsqrtf(ss * (1.f / 512.f) + EPSN);
      float4 ga = *(const float4*)(g + lane * 4), gb = *(const float4*)(g + 256 + lane * 4);
      uint2 oa = {pack2(a.x * rs * ga.x, a.y * rs * ga.y), pack2(a.z * rs * ga.z, a.w * rs * ga.w)};
      uint2 ob = {pack2(b.x * rs * gb.x, b.y * rs * gb.y), pack2(b.z * rs * gb.z, b.w * rs * gb.w)};
      *(uint2*)(cat + (size_t)r * 1024 + part * 512 + lane * 4) = oa;
      *(uint2*)(cat + (size_t)r * 1024 + part * 512 + 256 + lane * 4) = ob;
    }
  }
}

template <int MODE>
__device__ void phase_rn(const P& p) {
  const int lane = threadIdx.x & 63, w = threadIdx.x >> 6;
  char* ws = p.ws;
  const float* src = (const float*)(ws + (MODE == 1 ? OFF_D : OFF_MIX));
  const float* g1 = MODE == 0 ? p.g_post_mix : (MODE == 1 ? p.g_post_mlp : p.g_ple_post);
  const float* g2 = MODE == 0 ? p.g_pre_mlp : p.g_ple;
  u16* nxt = (u16*)(ws + OFF_ACT1);
  u16* pl = (u16*)(ws + OFF_PL);
  for (int r = blockIdx.x * 4 + w; r < T_ALL; r += gridDim.x * 4) {
    const float* s = src + (size_t)r * 1024;
    float* hy = p.out + (size_t)r * 1024;
    const float* base = MODE == 0 ? (r < T_P ? p.x_p + (size_t)r * 1024 : p.x_s + (size_t)(r - T_P) * 1024) : hy;
    float4 v[4];
    float ss = 0.f;
#pragma unroll
    for (int i = 0; i < 4; i++) {
      v[i] = *(const float4*)(s + i * 256 + lane * 4);
      ss += v[i].x * v[i].x + v[i].y * v[i].y + v[i].z * v[i].z + v[i].w * v[i].w;
    }
    ss = wave_sum(ss);
    float rs = rsqrtf(ss * (1.f / 1024.f) + EPSN);
    float ss2 = 0.f;
#pragma unroll
    for (int i = 0; i < 4; i++) {
      float4 g = *(const float4*)(g1 + i * 256 + lane * 4);
      float4 b = *(const float4*)(base + i * 256 + lane * 4);
      v[i].x = b.x + v[i].x * rs * g.x;
      v[i].y = b.y + v[i].y * rs * g.y;
      v[i].z = b.z + v[i].z * rs * g.z;
      v[i].w = b.w + v[i].w * rs * g.w;
      ss2 += v[i].x * v[i].x + v[i].y * v[i].y + v[i].z * v[i].z + v[i].w * v[i].w;
      *(float4*)(hy + i * 256 + lane * 4) = v[i];
    }
    if (MODE != 2) {
      ss2 = wave_sum(ss2);
      float rs2 = rsqrtf(ss2 * (1.f / 1024.f) + EPSN);
#pragma unroll
      for (int i = 0; i < 4; i++) {
        float4 g = *(const float4*)(g2 + i * 256 + lane * 4);
        uint2 o = {pack2(v[i].x * rs2 * g.x, v[i].y * rs2 * g.y), pack2(v[i].z * rs2 * g.z, v[i].w * rs2 * g.w)};
        *(uint2*)(nxt + (size_t)r * 1024 + i * 256 + lane * 4) = o;
      }
    }
    if (MODE == 1) {
      const float* pp = r < T_P ? p.p_p + (size_t)r * 256 : p.p_s + (size_t)(r - T_P) * 256;
      float4 a = *(const float4*)(pp + lane * 4);
      uint2 o = {pack2(a.x, a.y), pack2(a.z, a.w)};
      *(uint2*)(pl + (size_t)r * 256 + lane * 4) = o;
    }
  }
}

#define NPHASE 13
__global__ void __launch_bounds__(256, 2) mega(P p, int ph_lo, int ph_hi) {
  __shared__ __attribute__((aligned(16))) char smem[36864];
  cg::grid_group grid = cg::this_grid();
  char* ws = p.ws;
  if (ph_lo <= 0 && 0 < ph_hi) {
 phase0(p, smem);
    if (0 + 1 < ph_hi) grid.sync();
  }
  if (ph_lo <= 1 && 1 < ph_hi) {
        for (int t = blockIdx.x; t < 264 * 18; t += gridDim.x)
          gemm_tile<EPI_IN>(p, (const u16*)(ws + OFF_ACT1), 1024, (const u16*)(ws + OFF_WIN), 1024, (t / 18) * 128,
                            (t % 18) * 128, nullptr, 0, smem);
    if (1 + 1 < ph_hi) grid.sync();
  }
  if (ph_lo <= 2 && 2 < ph_hi) {
 phase_r2(p);
    if (2 + 1 < ph_hi) grid.sync();
  }
  if (ph_lo <= 3 && 3 < ph_hi) {
 {
        for (int t = blockIdx.x; t < 36 + 1584 + 6208; t += gridDim.x) {
          if (t < 36) scan_seq(p, t, smem);
          else if (t < 36 + 1584) {
            int j = t - 36;
            gemm_tile<EPI_BF16>(p, (const u16*)p.out, 384, (const u16*)(ws + OFF_WQ), 384, (j / 6) * 128,
                                (j % 6) * 128, ws + OFF_ACT1, 768, smem);
          } else {
            int j = t - 36 - 1584;
            gemm_tile<EPI_KV>(p, (const u16*)((char*)p.out + (size_t)T_ALL * 384 * 2), 256,
                              (const u16*)(ws + OFF_WKV), 256, (j >> 3) * 128, (j & 7) * 128, nullptr, 0, smem);
          }
        }
      }
    if (3 + 1 < ph_hi) grid.sync();
  }
  if (ph_lo <= 4 && 4 < ph_hi) {
 phase_attn(p, smem);
    if (4 + 1 < ph_hi) grid.sync();
  }
  if (ph_lo <= 5 && 5 < ph_hi) {
 phase_r3(p);
    if (5 + 1 < ph_hi) grid.sync();
  }
  if (ph_lo <= 6 && 6 < ph_hi) {

        for (int t = blockIdx.x; t < 264 * 8; t += gridDim.x)
          gemm_tile<EPI_F32>(p, (const u16*)(ws + OFF_ACT1), 1024, (const u16*)(ws + OFF_WO), 1024, (t >> 3) * 128,
                             (t & 7) * 128, ws + OFF_MIX, 1024, smem);
    if (6 + 1 < ph_hi) grid.sync();
  }
  if (ph_lo <= 7 && 7 < ph_hi) {
 phase_rn<0>(p);
    if (7 + 1 < ph_hi) grid.sync();
  }
  if (ph_lo <= 8 && 8 < ph_hi) {

        for (int t = blockIdx.x; t < 264 * 32; t += gridDim.x)
          gemm_tile<EPI_RELU2>(p, (const u16*)(ws + OFF_ACT1), 1024, (const u16*)(ws + OFF_WUP), 1024,
                               (t >> 5) * 128, (t & 31) * 128, ws + OFF_ACT, 4096, smem);
    if (8 + 1 < ph_hi) grid.sync();
  }
  if (ph_lo <= 9 && 9 < ph_hi) {

        for (int t = blockIdx.x; t < 264 * 8; t += gridDim.x)
          gemm_tile<EPI_F32>(p, (const u16*)(ws + OFF_ACT), 4096, (const u16*)(ws + OFF_WDN), 4096, (t >> 3) * 128,
                             (t & 7) * 128, ws + OFF_D, 1024, smem);
    if (9 + 1 < ph_hi) grid.sync();
  }
  if (ph_lo <= 10 && 10 < ph_hi) {
 phase_rn<1>(p);
    if (10 + 1 < ph_hi) grid.sync();
  }
  if (ph_lo <= 11 && 11 < ph_hi) {

        for (int t = blockIdx.x; t < 264 * 8; t += gridDim.x) {
          gemm_tile<EPI_GATE>(p, (const u16*)(ws + OFF_ACT1), 1024, (const u16*)(ws + OFF_WG), 1024, (t >> 3) * 128,
                              (t & 7) * 128, ws + OFF_MIX, 1024, smem);
          gemm_tile<EPI_PROD>(p, (const u16*)(ws + OFF_PL), 256, (const u16*)(ws + OFF_WPJ), 256, (t >> 3) * 128,
                              (t & 7) * 128, ws + OFF_MIX, 1024, smem);
        }
    if (11 + 1 < ph_hi) grid.sync();
  }
  if (ph_lo <= 12 && 12 < ph_hi) {
 phase_rn<2>(p);
    if (12 + 1 < ph_hi) grid.sync();
  }
}

extern "C" void kernel_launch(void* const* d_in, const int* in_sizes, int n_in, void* d_out, int out_size,
                              void* d_ws, size_t ws_size, hipStream_t stream) {
  static int grid_blocks = 0;
  if (!grid_blocks) {
    int dev = 0, cus = 0, per_cu = 0;
    hipGetDevice(&dev);
    hipDeviceGetAttribute(&cus, hipDeviceAttributeMultiprocessorCount, dev);
    hipOccupancyMaxActiveBlocksPerMultiprocessor(&per_cu, mega, 256, 0);
    if (per_cu < 1) per_cu = 1;
    if (per_cu > 2) per_cu = 2;
    grid_blocks = cus * per_cu;
  }
  if (ws_size < OFF_END + 65536) {
    fprintf(stderr, "workspace too small: %zu < %zu\n", ws_size, (size_t)OFF_END);
    return;
  }
  P p{};
  const float** f = (const float**)&p;
  for (int i = 0; i < 28; i++) f[i] = (const float*)d_in[i];
  p.out = (float*)d_out;
  p.ws = (char*)d_ws;
#if COOP
  int lo = 0, hi = NPHASE;
  void* args[] = {&p, &lo, &hi};
  hipError_t e = hipLaunchCooperativeKernel((void*)mega, dim3(grid_blocks), dim3(256), args, 0, stream);
  if (e != hipSuccess) fprintf(stderr, "cooperative launch failed: %s (grid %d)\n", hipGetErrorString(e), grid_blocks);
#else
  for (int ph = 0; ph < NPHASE; ph++) mega<<<grid_blocks, 256, 0, stream>>>(p, ph, ph + 1);
#endif
}
```

```cpp
#include <hip/hip_runtime.h>
#include <hip/hip_cooperative_groups.h>
#include <cstdio>
namespace cg = cooperative_groups;

typedef unsigned short u16;
using bf16x8 = __attribute__((ext_vector_type(8))) short;
using f32x16 = __attribute__((ext_vector_type(16))) float;
using u32x4 = __attribute__((ext_vector_type(4))) unsigned;

#define T_P 32768
#define T_ALL 33792
#define U_ALL 99328
#define USL (U_ALL + 64)
#define LOG2E 1.4426950408889634f
#define EPSN 1e-6f

#ifndef COOP
#define COOP 1
#endif
#ifndef REPEAT
#define REPEAT 0
#endif

constexpr size_t SZ_WIN = 2304ull * 1024 * 2, SZ_WQ = 768ull * 384 * 2, SZ_WKV = 1024ull * 256 * 2,
                 SZ_WO = 1024ull * 1024 * 2, SZ_WUP = 4096ull * 1024 * 2, SZ_WDN = 1024ull * 4096 * 2,
                 SZ_WG = 1024ull * 1024 * 2, SZ_WPJ = 1024ull * 256 * 2, SZ_ROPE = 8192ull * 16 * 4;
constexpr size_t OFF_WIN = 0, OFF_WQ = OFF_WIN + SZ_WIN, OFF_WKV = OFF_WQ + SZ_WQ, OFF_WO = OFF_WKV + SZ_WKV,
                 OFF_WUP = OFF_WO + SZ_WO, OFF_WDN = OFF_WUP + SZ_WUP, OFF_WG = OFF_WDN + SZ_WDN,
                 OFF_WPJ = OFF_WG + SZ_WG, OFF_COS = OFF_WPJ + SZ_WPJ, OFF_SIN = OFF_COS + SZ_ROPE,
                 OFF_ACT1 = OFF_SIN + SZ_ROPE;
constexpr size_t SZ_ACT1 = (size_t)T_ALL * 1024 * 2;
constexpr size_t OFF_POOL = OFF_ACT1 + SZ_ACT1;
constexpr size_t OFF_QF = OFF_POOL, SZ_QF = (size_t)T_ALL * 512 * 2;
constexpr size_t OFF_KPE = OFF_QF + SZ_QF, SZ_KPE = (size_t)USL * 32 * 2;
constexpr size_t OFF_LOGF = OFF_KPE + SZ_KPE, SZ_LOGF = (size_t)USL * 8 * 4;
constexpr size_t OFF_C2 = OFF_LOGF + SZ_LOGF;
constexpr size_t OFF_KF = OFF_C2 + SZ_LOGF, SZ_KF = (size_t)USL * 512 * 2;
constexpr size_t OFF_VTF = OFF_KF + SZ_KF;
constexpr size_t OFF_KN = OFF_VTF + SZ_KF;
constexpr size_t OFF_ZV = OFF_KN + SZ_KF;
constexpr size_t SZ_ZV = (size_t)T_ALL * 768 * 4;
constexpr size_t OFF_END = OFF_ZV + SZ_ZV;
constexpr size_t OFF_BAR = OFF_END + 4096;
constexpr size_t OFF_MIX = OFF_POOL;
constexpr size_t OFF_ACT = OFF_POOL;
constexpr size_t OFF_D = OFF_POOL + (size_t)T_ALL * 4096 * 2;
constexpr size_t OFF_PL = OFF_D + (size_t)T_ALL * 1024 * 4;
static_assert(OFF_PL + (size_t)T_ALL * 256 * 2 <= OFF_END, "pool too small");
static_assert((size_t)USL * 512 * 2 <= SZ_ZV, "zv");

constexpr size_t O_Y = 0, O_FKP = 34603008ull, O_FVP = 51380224ull, O_LFP = 68157440ull, O_CKVP = 68419584ull,
                 O_KPEP = 76808192ull, O_FKS = 77856768ull, O_FVS = 78381056ull, O_LFS = 78905344ull,
                 O_CKVS = 78913536ull, O_KPES = 79175680ull;

struct P {
  const float *x_p, *x_s, *p_p, *p_s, *c_fk, *c_fv, *c_lf, *c_ckv, *c_kpe;
  const float *g_pre_mix, *w_in, *b_fox_f, *g_mla_q, *w_q_up, *g_mla_kv, *w_kv_up, *g_fox_out, *g_mla_out, *w_out,
      *g_post_mix, *g_pre_mlp, *w_up, *w_down, *g_post_mlp, *g_ple, *w_gate, *w_proj, *g_ple_post;
  float* out;
  char* ws;
};

__device__ __forceinline__ u16 f2bf(float f) {
  unsigned u = __float_as_uint(f);
  u += 0x7fffu + ((u >> 16) & 1u);
  return (u16)(u >> 16);
}
__device__ __forceinline__ float bf2f(u16 v) { return __uint_as_float(((unsigned)v) << 16); }
__device__ __forceinline__ unsigned pack2(float a, float b) { return (unsigned)f2bf(a) | ((unsigned)f2bf(b) << 16); }
__device__ __forceinline__ float wave_sum(float v) {
#pragma unroll
  for (int o = 32; o > 0; o >>= 1) v += __shfl_xor(v, o);
  return v;
}
__device__ __forceinline__ int urow(int r) {
  return r < T_P ? r : T_P + ((r - T_P) >> 5) * 2080 + 2048 + ((r - T_P) & 31);
}
__device__ __forceinline__ float fast_exp2(float x) { return __builtin_amdgcn_exp2f(x); }


#define XB_TMO      128
#define XB_XCNT(j)  (256  + 64 * (j))
#define XB_XSUB(j)  (1280 + 64 * (j))
#define XB_XGEN(j)  (2304 + 64 * (j))
#define XB_TOP      3328
#define XB_TOPGEN   3392
#define XCD_BAR_WORDS 3456
#define XB_SPIN_CAP (1u << 22)
#define LAS __attribute__((address_space(3)))
__device__ __forceinline__ unsigned xb_ld(unsigned* p) { return __hip_atomic_load(p, __ATOMIC_RELAXED, __HIP_MEMORY_SCOPE_AGENT); }
__device__ __forceinline__ unsigned xb_add(unsigned* p, unsigned v) { return __hip_atomic_fetch_add(p, v, __ATOMIC_RELAXED, __HIP_MEMORY_SCOPE_AGENT); }
__device__ __forceinline__ unsigned xb_xcc_id() { return (unsigned)__builtin_amdgcn_s_getreg((3 << 11) | 20) & 0xFu; }
#define XB_SPIN(cond, bar) do { unsigned _sp = 0; while (cond) { __builtin_amdgcn_s_sleep(1); \
    if ((++_sp & 255u) == 0u) { if (xb_ld(&(bar)[XB_TMO])) break; if (_sp > XB_SPIN_CAP) { atomicAdd(&(bar)[XB_TMO], 1u); break; } } } } while (0)
struct XcdBarrier { unsigned* bar; unsigned x; volatile LAS unsigned* st; };
__device__ __forceinline__ XcdBarrier xcd_barrier_post(unsigned* bar, volatile LAS unsigned* st) {
  XcdBarrier b; b.bar = bar; b.x = xb_xcc_id(); b.st = st;
  if (threadIdx.x == 0) (void)xb_add(&bar[XB_XCNT(b.x)], 1u);
  return b;
}
__device__ __forceinline__ void xcd_barrier_complete(unsigned* bar, unsigned x, unsigned& nloc, unsigned& nx) {
  const unsigned G = gridDim.x * gridDim.y * gridDim.z;
  unsigned sum, cnt, mine, sp = 0u;
  for (;;) {
    sum = 0u; cnt = 0u; mine = 0u;
#pragma unroll
    for (unsigned j = 0; j < 16; ++j) { const unsigned c = xb_ld(&bar[XB_XCNT(j)]); sum += c; cnt += (c > 0u) ? 1u : 0u; mine = (j == x) ? c : mine; }
    if (sum == G) break;
    __builtin_amdgcn_s_sleep(1);
    if ((++sp & 255u) == 0u) { if (xb_ld(&bar[XB_TMO])) break; if (sp > XB_SPIN_CAP) { atomicAdd(&bar[XB_TMO], 1u); break; } }
  }
  nloc = mine > 0u ? mine : 1u; nx = cnt > 0u ? cnt : 1u;
}
__device__ __forceinline__ void xcd_barrier(const XcdBarrier& b) {
  asm volatile("s_waitcnt vmcnt(0)" ::: "memory");
  __syncthreads();
  if (threadIdx.x == 0) {
    unsigned* bar = b.bar;
    __builtin_amdgcn_s_waitcnt(0);
    unsigned nloc = b.st[0], nx = b.st[1];
    if (nloc == 0u) { xcd_barrier_complete(bar, b.x, nloc, nx); b.st[0] = nloc; b.st[1] = nx; }
    const unsigned old = xb_add(&bar[XB_XSUB(b.x)], 1u);
    const unsigned gen = old / nloc;
    if (old + 1u == (gen + 1u) * nloc) {
      __builtin_amdgcn_fence(__ATOMIC_RELEASE, "agent");
      asm volatile("s_waitcnt vmcnt(0)" ::: "memory");
      const unsigned og = xb_add(&bar[XB_TOP], 1u);
      const unsigned tg = og / nx;
      if (og + 1u == (tg + 1u) * nx) xb_add(&bar[XB_TOPGEN], 1u);
      else XB_SPIN(xb_ld(&bar[XB_TOPGEN]) == tg, bar);
      __builtin_amdgcn_fence(__ATOMIC_ACQUIRE, "agent");
      xb_add(&bar[XB_XGEN(b.x)], 1u);
      asm volatile("s_waitcnt vmcnt(0)" ::: "memory");
    } else {
      XB_SPIN(xb_ld(&bar[XB_XGEN(b.x)]) == gen, bar);
      __builtin_amdgcn_fence(__ATOMIC_ACQUIRE, "agent");
      asm volatile("s_waitcnt vmcnt(0)" ::: "memory");
    }
  }
  __syncthreads();
}

__device__ __forceinline__ int winmap(int c) {
  if (c < 1536) return c;
  if (c < 2208) return c + 8;
  if (c < 2216) return c - 672;
  return -1;
}

__device__ __forceinline__ void transpose_tile(const float* __restrict__ src, int ld_s, u16* __restrict__ dst,
                                               size_t ld_d, int r0, int c0, int mode, float* lds) {
  const int tx = threadIdx.x & 63, ty = threadIdx.x >> 6;
#pragma unroll 4
  for (int i = 0; i < 16; i++) {
    int r = i * 4 + ty;
    int c = c0 + tx;
    int cs = mode ? winmap(c) : c;
    float v = (cs >= 0) ? src[(size_t)(r0 + r) * ld_s + cs] : 0.f;
    lds[r * 65 + tx] = v;
  }
  __syncthreads();
#pragma unroll 4
  for (int i = 0; i < 16; i++) {
    int c = i * 4 + ty;
    dst[(size_t)(c0 + c) * ld_d + r0 + tx] = f2bf(lds[tx * 65 + c]);
  }
  __syncthreads();
}

__device__ void transpose_weight(const float* src, int K, int Nsrc, int Npad, u16* dst, int mode, float* lds) {
  const int nct = Npad / 64, nt = (K / 64) * nct;
  for (int t = blockIdx.x; t < nt; t += gridDim.x) {
    int rt = t / nct, ct = t % nct;
    transpose_tile(src, Nsrc, dst, (size_t)K, rt * 64, ct * 64, mode, lds);
  }
}

__constant__ float ROPE_INV[16] = {1.000000000e+00f, 5.623413324e-01f, 3.162277639e-01f, 1.778279394e-01f,
                                   1.000000015e-01f, 5.623413250e-02f, 3.162277490e-02f, 1.778279431e-02f,
                                   9.999999776e-03f, 5.623413250e-03f, 3.162277630e-03f, 1.778279431e-03f,
                                   1.000000047e-03f, 5.623413017e-04f, 3.162277571e-04f, 1.778279402e-04f};

__device__ void phase0(const P& p, char* smem) {
  char* ws = p.ws;
  float* lds = (float*)smem;
  transpose_weight(p.w_in, 1024, 2216, 2304, (u16*)(ws + OFF_WIN), 1, lds);
  transpose_weight(p.w_q_up, 384, 768, 768, (u16*)(ws + OFF_WQ), 0, lds);
  transpose_weight(p.w_kv_up, 256, 1024, 1024, (u16*)(ws + OFF_WKV), 0, lds);
  transpose_weight(p.w_out, 1024, 1024, 1024, (u16*)(ws + OFF_WO), 0, lds);
  transpose_weight(p.w_up, 1024, 4096, 4096, (u16*)(ws + OFF_WUP), 0, lds);
  transpose_weight(p.w_down, 4096, 1024, 1024, (u16*)(ws + OFF_WDN), 0, lds);
  transpose_weight(p.w_gate, 1024, 1024, 1024, (u16*)(ws + OFF_WG), 0, lds);
  transpose_weight(p.w_proj, 256, 1024, 1024, (u16*)(ws + OFF_WPJ), 0, lds);
  for (int it = blockIdx.x; it < 8192; it += gridDim.x) {
    int b = it >> 8, rt = (it >> 3) & 31, ct = it & 7;
    transpose_tile(p.c_fv + (size_t)b * 2048 * 512, 512, (u16*)(ws + OFF_VTF) + (size_t)(T_P + b * 2080) * 512,
                   (size_t)2080, rt * 64, ct * 64, 0, lds);
  }
  const size_t gtid = (size_t)blockIdx.x * 256 + threadIdx.x, gsz = (size_t)gridDim.x * 256;
  {
    float* cosT = (float*)(ws + OFF_COS);
    float* sinT = (float*)(ws + OFF_SIN);
    for (size_t i = gtid; i < 8192 * 16; i += gsz) {
      int pos = (int)(i >> 4), k = (int)(i & 15);
      float ang = (float)pos * ROPE_INV[k];
      cosT[i] = cosf(ang);
      sinT[i] = sinf(ang);
    }
  }
  {
    u16* Kf = (u16*)(ws + OFF_KF);
    for (size_t c = gtid; c < (size_t)65536 * 64; c += gsz) {
      size_t e = c * 8;
      int row = (int)(e >> 9), col = (int)(e & 511);
      int u = T_P + (row >> 11) * 2080 + (row & 2047);
      float4 a = *(const float4*)(p.c_fk + e), b = *(const float4*)(p.c_fk + e + 4);
      uint4 o = {pack2(a.x, a.y), pack2(a.z, a.w), pack2(b.x, b.y), pack2(b.z, b.w)};
      *(uint4*)(Kf + (size_t)u * 512 + col) = o;
    }
  }
  {
    u16* ckvb = (u16*)((char*)p.out + (size_t)T_ALL * 384 * 2);
    for (size_t c = gtid; c < (size_t)65536 * 32; c += gsz) {
      size_t e = c * 8;
      int row = (int)(e >> 8), col = (int)(e & 255);
      int u = T_P + (row >> 11) * 2080 + (row & 2047);
      float4 a = *(const float4*)(p.c_ckv + e), b = *(const float4*)(p.c_ckv + e + 4);
      uint4 o = {pack2(a.x, a.y), pack2(a.z, a.w), pack2(b.x, b.y), pack2(b.z, b.w)};
      *(uint4*)(ckvb + (size_t)u * 256 + col) = o;
    }
  }
  {
    u16* kpeb = (u16*)(ws + OFF_KPE);
    for (size_t c = gtid; c < (size_t)65536 * 4; c += gsz) {
      size_t e = c * 8;
      int row = (int)(e >> 5), col = (int)(e & 31);
      int u = T_P + (row >> 11) * 2080 + (row & 2047);
      float4 a = *(const float4*)(p.c_kpe + e), b = *(const float4*)(p.c_kpe + e + 4);
      uint4 o = {pack2(a.x, a.y), pack2(a.z, a.w), pack2(b.x, b.y), pack2(b.z, b.w)};
      *(uint4*)(kpeb + (size_t)u * 32 + col) = o;
    }
  }
  {
    float* lw = (float*)(ws + OFF_LOGF);
    for (size_t c = gtid; c < (size_t)65536 * 2; c += gsz) {
      size_t e = c * 4;
      int row = (int)(e >> 3), col = (int)(e & 7);
      int u = T_P + (row >> 11) * 2080 + (row & 2047);
      *(float4*)(lw + (size_t)u * 8 + col) = *(const float4*)(p.c_lf + e);
    }
  }
  {
    const int lane = threadIdx.x & 63, w = threadIdx.x >> 6;
    u16* xn = (u16*)(ws + OFF_ACT1);
    for (int r = blockIdx.x * 4 + w; r < T_ALL; r += gridDim.x * 4) {
      const float* x = r < T_P ? p.x_p + (size_t)r * 1024 : p.x_s + (size_t)(r - T_P) * 1024;
      float4 v[4];
      float ss = 0.f;
#pragma unroll
      for (int i = 0; i < 4; i++) {
        v[i] = *(const float4*)(x + i * 256 + lane * 4);
        ss += v[i].x * v[i].x + v[i].y * v[i].y + v[i].z * v[i].z + v[i].w * v[i].w;
      }
      ss = wave_sum(ss);
      float rs = rsqrtf(ss * (1.f / 1024.f) + EPSN);
#pragma unroll
      for (int i = 0; i < 4; i++) {
        float4 g = *(const float4*)(p.g_pre_mix + i * 256 + lane * 4);
        uint2 o = {pack2(v[i].x * rs * g.x, v[i].y * rs * g.y), pack2(v[i].z * rs * g.z, v[i].w * rs * g.w)};
        *(uint2*)(xn + (size_t)r * 1024 + i * 256 + lane * 4) = o;
      }
    }
  }
}

enum { EPI_IN = 0, EPI_BF16 = 1, EPI_KV = 2, EPI_F32 = 3, EPI_RELU2 = 4, EPI_GATE = 5, EPI_PROD = 6 };

template <int EPI>
__device__ __forceinline__ void gemm_tile(const P& p, const u16* __restrict__ A, int lda,
                                          const u16* __restrict__ Bt, int K, int m0, int n0, void* Cptr, int ldc,
                                          char* smem) {
  u16* sA = (u16*)smem;
  u16* sB = sA + 128 * 72;
  const int tid = threadIdx.x, lane = tid & 63, w = tid >> 6, wm = w >> 1, wn = w & 1;
  const int l31 = lane & 31, hh = lane >> 5;
  f32x16 acc[2][2];
#pragma unroll
  for (int i = 0; i < 2; i++)
#pragma unroll
    for (int j = 0; j < 2; j++)
#pragma unroll
      for (int r = 0; r < 16; r++) acc[i][j][r] = 0.f;

  const int lr = tid >> 3, lc = (tid & 7) * 8;
  const u16* Ap = A + (size_t)(m0 + lr) * lda + lc;
  const u16* Bp = Bt + (size_t)(n0 + lr) * K + lc;
  u32x4 ra[4], rb[4];
#pragma unroll
  for (int i = 0; i < 4; i++) {
    ra[i] = *(const u32x4*)(Ap + (size_t)i * 32 * lda);
    rb[i] = *(const u32x4*)(Bp + (size_t)i * 32 * K);
  }
  const int nk = K >> 6;
  for (int kt = 0; kt < nk; kt++) {
#pragma unroll
    for (int i = 0; i < 4; i++) {
      *(u32x4*)&sA[(lr + i * 32) * 72 + lc] = ra[i];
      *(u32x4*)&sB[(lr + i * 32) * 72 + lc] = rb[i];
    }
    __syncthreads();
    if (kt + 1 < nk) {
#pragma unroll
      for (int i = 0; i < 4; i++) {
        ra[i] = *(const u32x4*)(Ap + (size_t)i * 32 * lda + (kt + 1) * 64);
        rb[i] = *(const u32x4*)(Bp + (size_t)i * 32 * K + (kt + 1) * 64);
      }
    }
#pragma unroll
    for (int ks = 0; ks < 4; ks++) {
      bf16x8 a0 = *(const bf16x8*)&sA[(wm * 64 + l31) * 72 + ks * 16 + hh * 8];
      bf16x8 a1 = *(const bf16x8*)&sA[(wm * 64 + 32 + l31) * 72 + ks * 16 + hh * 8];
      bf16x8 b0 = *(const bf16x8*)&sB[(wn * 64 + l31) * 72 + ks * 16 + hh * 8];
      bf16x8 b1 = *(const bf16x8*)&sB[(wn * 64 + 32 + l31) * 72 + ks * 16 + hh * 8];
      acc[0][0] = __builtin_amdgcn_mfma_f32_32x32x16_bf16(a0, b0, acc[0][0], 0, 0, 0);
      acc[0][1] = __builtin_amdgcn_mfma_f32_32x32x16_bf16(a0, b1, acc[0][1], 0, 0, 0);
      acc[1][0] = __builtin_amdgcn_mfma_f32_32x32x16_bf16(a1, b0, acc[1][0], 0, 0, 0);
      acc[1][1] = __builtin_amdgcn_mfma_f32_32x32x16_bf16(a1, b1, acc[1][1], 0, 0, 0);
    }
    __syncthreads();
  }

  char* ws = p.ws;
#pragma unroll
  for (int mi = 0; mi < 2; mi++)
#pragma unroll
    for (int ni = 0; ni < 2; ni++)
#pragma unroll
      for (int g = 0; g < 4; g++) {
        const int row = m0 + wm * 64 + mi * 32 + 8 * g + 4 * hh;
        const int col = n0 + wn * 64 + ni * 32 + l31;
        float v[4];
#pragma unroll
        for (int j = 0; j < 4; j++) v[j] = acc[mi][ni][4 * g + j];
        if (EPI == EPI_IN) {
          const int nt = n0 >> 7;
          if (nt < 4) {
            u16* Qf = (u16*)(ws + OFF_QF);
#pragma unroll
            for (int j = 0; j < 4; j++) Qf[(size_t)(row + j) * 512 + col] = f2bf(v[j]);
          } else if (nt < 8) {
            const int cc = col - 512;
            u16* Kf = (u16*)(ws + OFF_KF);
            float* o = row < T_P ? p.out + O_FKP + (size_t)row * 512 : p.out + O_FKS + (size_t)(row - T_P) * 512;
            const int u = urow(row);
#pragma unroll
            for (int j = 0; j < 4; j++) {
              o[(size_t)j * 512 + cc] = v[j];
              Kf[(size_t)(u + j) * 512 + cc] = f2bf(v[j]);
            }
          } else if (nt < 12) {
            const int cc = col - 1024;
            float* o = row < T_P ? p.out + O_FVP + (size_t)row * 512 : p.out + O_FVS + (size_t)(row - T_P) * 512;
#pragma unroll
            for (int j = 0; j < 4; j++) o[(size_t)j * 512 + cc] = v[j];
            size_t vbase;
            int pos, len;
            if (row < T_P) {
              vbase = (size_t)(row >> 13) * 8192 * 512; pos = row & 8191; len = 8192;
            } else {
              int rr = row - T_P;
              vbase = (size_t)(T_P + (rr >> 5) * 2080) * 512; pos = 2048 + (rr & 31); len = 2080;
            }
            u16* Vt = (u16*)(ws + OFF_VTF);
            uint2 pk = {pack2(v[0], v[1]), pack2(v[2], v[3])};
            *(uint2*)(Vt + vbase + (size_t)cc * len + pos) = pk;
          } else {
            float* zz = (float*)(ws + OFF_ZV);
#pragma unroll
            for (int j = 0; j < 4; j++) zz[(size_t)(row + j) * 768 + (col - 1536)] = v[j];
          }
        } else if (EPI == EPI_BF16) {
          u16* C = (u16*)Cptr;
#pragma unroll
          for (int j = 0; j < 4; j++) C[(size_t)(row + j) * ldc + col] = f2bf(v[j]);
        } else if (EPI == EPI_KV) {
          const int h = n0 >> 7;
          if (wn == 0) {
            u16* Kn = (u16*)(ws + OFF_KN);
            const int d = col - n0;
#pragma unroll
            for (int j = 0; j < 4; j++) Kn[(size_t)(row + j) * 512 + h * 64 + d] = f2bf(v[j]);
          } else {
            const int d = col - n0 - 64;
            size_t vbase;
            int pos, len;
            if (row < T_P) {
              vbase = (size_t)(row >> 13) * 8192 * 512; pos = row & 8191; len = 8192;
            } else {
              int rr = row - T_P;
              int b = rr / 2080;
              vbase = (size_t)(T_P + b * 2080) * 512; pos = rr - b * 2080; len = 2080;
            }
            u16* Vt = (u16*)(ws + OFF_ZV);
            uint2 pk = {pack2(v[0], v[1]), pack2(v[2], v[3])};
            *(uint2*)(Vt + vbase + (size_t)(h * 64 + d) * len + pos) = pk;
          }
        } else if (EPI == EPI_F32) {
          float* C = (float*)Cptr;
#pragma unroll
          for (int j = 0; j < 4; j++) C[(size_t)(row + j) * ldc + col] = v[j];
        } else if (EPI == EPI_RELU2) {
          u16* C = (u16*)Cptr;
#pragma unroll
          for (int j = 0; j < 4; j++) {
            float t = fmaxf(v[j], 0.f);
            C[(size_t)(row + j) * ldc + col] = f2bf(t * t);
          }
        } else if (EPI == EPI_GATE) {
          float* C = (float*)Cptr;
#pragma unroll
          for (int j = 0; j < 4; j++) C[(size_t)(row + j) * ldc + col] = 1.f / (1.f + __expf(-v[j]));
        } else if (EPI == EPI_PROD) {
          float* C = (float*)Cptr;
#pragma unroll
          for (int j = 0; j < 4; j++) {
            size_t a = (size_t)(row + j) * ldc + col;
            C[a] = C[a] * v[j];
          }
        }
      }
}

__device__ void phase_r2(const P& p) {
  char* ws = p.ws;
  const int lane = threadIdx.x & 63, w = threadIdx.x >> 6;
  const float* zz = (const float*)(ws + OFF_ZV);
  u16* qn = (u16*)p.out;
  u16* ckvb = (u16*)((char*)p.out + (size_t)T_ALL * 384 * 2);
  u16* kpeb = (u16*)(ws + OFF_KPE);
  float* lw = (float*)(ws + OFF_LOGF);
  const float* cosT = (const float*)(ws + OFF_COS);
  const float* sinT = (const float*)(ws + OFF_SIN);
  for (int r = blockIdx.x * 4 + w; r < T_ALL; r += gridDim.x * 4) {
    const float* z = zz + (size_t)r * 768;
    const int u = urow(r);
    const bool pr = r < T_P;
    const int rs_ = r - T_P;
    {
      float4 a = *(const float4*)(z + lane * 4);
      float2 b = *(const float2*)(z + 256 + lane * 2);
      float ss = a.x * a.x + a.y * a.y + a.z * a.z + a.w * a.w + b.x * b.x + b.y * b.y;
      ss = wave_sum(ss);
      float rs = rsqrtf(ss * (1.f / 384.f) + EPSN);
      float4 g = *(const float4*)(p.g_mla_q + lane * 4);
      float2 g2 = *(const float2*)(p.g_mla_q + 256 + lane * 2);
      uint2 o = {pack2(a.x * rs * g.x, a.y * rs * g.y), pack2(a.z * rs * g.z, a.w * rs * g.w)};
      *(uint2*)(qn + (size_t)r * 384 + lane * 4) = o;
      *(unsigned*)(qn + (size_t)r * 384 + 256 + lane * 2) = pack2(b.x * rs * g2.x, b.y * rs * g2.y);
    }
    {
      float4 a = *(const float4*)(z + 384 + lane * 4);
      float ss = a.x * a.x + a.y * a.y + a.z * a.z + a.w * a.w;
      ss = wave_sum(ss);
      float rs = rsqrtf(ss * (1.f / 256.f) + EPSN);
      float4 g = *(const float4*)(p.g_mla_kv + lane * 4);
      float4 o = {a.x * rs * g.x, a.y * rs * g.y, a.z * rs * g.z, a.w * rs * g.w};
      float* oc = pr ? p.out + O_CKVP + (size_t)r * 256 : p.out + O_CKVS + (size_t)rs_ * 256;
      *(float4*)(oc + lane * 4) = o;
      uint2 ob = {pack2(o.x, o.y), pack2(o.z, o.w)};
      *(uint2*)(ckvb + (size_t)u * 256 + lane * 4) = ob;
    }
    if (lane < 16) {
      const int pos = pr ? (r & 8191) : 2048 + (rs_ & 31);
      float x1 = z[640 + lane], x2 = z[656 + lane];
      float c = cosT[pos * 16 + lane], s = sinT[pos * 16 + lane];
      float o1 = x1 * c - x2 * s, o2 = x1 * s + x2 * c;
      float* ok = pr ? p.out + O_KPEP + (size_t)r * 32 : p.out + O_KPES + (size_t)rs_ * 32;
      ok[lane] = o1;
      ok[16 + lane] = o2;
      kpeb[(size_t)u * 32 + lane] = f2bf(o1);
      kpeb[(size_t)u * 32 + 16 + lane] = f2bf(o2);
    }
    if (lane < 8) {
      float x = z[672 + lane] + p.b_fox_f[lane];
      float lf = fminf(x, 0.f) - log1pf(expf(-fabsf(x)));
      float* ol = pr ? p.out + O_LFP + (size_t)r * 8 : p.out + O_LFS + (size_t)rs_ * 8;
      ol[lane] = lf;
      lw[(size_t)u * 8 + lane] = lf;
    }
  }
}

__device__ void scan_seq(const P& p, int seq, char* smem) {
  float* tot = (float*)smem;
  const float* lw = (const float*)(p.ws + OFF_LOGF);
  float* c2 = (float*)(p.ws + OFF_C2);
  const int tid = threadIdx.x, h = tid & 7, sg = tid >> 3;
  const int len = seq < 4 ? 8192 : 2080;
  const int rowbase = seq < 4 ? seq * 8192 : T_P + (seq - 4) * 2080;
  const int sl = len / 32;
  const size_t b0 = ((size_t)rowbase + (size_t)sg * sl) * 8 + h;
  float s = 0.f;
#pragma unroll 8
  for (int i = 0; i < sl; i++) s += lw[b0 + (size_t)i * 8];
  tot[sg * 8 + h] = s;
  __syncthreads();
  float run = 0.f;
  for (int j = 0; j < sg; j++) run += tot[j * 8 + h];
#pragma unroll 8
  for (int i = 0; i < sl; i++) {
    run += lw[b0 + (size_t)i * 8];
    c2[b0 + (size_t)i * 8] = run * LOG2E;
  }
  __syncthreads();
}

template <int DK, bool FOX>
__device__ __forceinline__ void attn_item(const P& p, int seq, int h, int qb, char* smem) {
  constexpr int KS = DK + 8;
  constexpr int VS = 68;
  constexpr int NKS = DK / 16;
  constexpr int NKC = DK / 8;
  constexpr int NKL = (64 * NKC) / 256;
  u16* sK = (u16*)smem;
  u16* sV = sK + 64 * KS;
  float* sC = (float*)(sV + 64 * VS);
  char* ws = p.ws;
  const int tid = threadIdx.x, lane = tid & 63, w = tid >> 6, l31 = lane & 31, hh = lane >> 5;

  const u16* Q = (const u16*)(ws + (FOX ? OFF_QF : OFF_ACT1));
  const int ldq = FOX ? 512 : 768;
  const u16* Kb = (const u16*)(ws + (FOX ? OFF_KF : OFF_KN));
  const u16* kpeb = (const u16*)(ws + OFF_KPE);
  const u16* Vt = (const u16*)(ws + (FOX ? OFF_VTF : OFF_ZV));
  const float* c2 = (const float*)(ws + OFF_C2);
  float* O = p.out + (FOX ? 0 : (size_t)T_ALL * 512);

  const bool prompt = seq < 4;
  const int len = prompt ? 8192 : 2080;
  const int rowbase = prompt ? seq * 8192 : T_P + (seq - 4) * 2080;
  const int qpos0 = prompt ? qb * 128 : 2048;
  const int qtok0 = prompt ? seq * 8192 + qb * 128 : T_P + (seq - 4) * 32;
  const bool wvalid = prompt || w == 0;
  const int wq = wvalid ? w * 32 : 0;
  const int qpos = qpos0 + wq + l31;
  const int qtok = qtok0 + wq + l31;
  int lim, lim_min, lim_max;
  if (FOX) { lim = qpos; lim_min = qpos0 + wq; lim_max = lim_min + 31; }
  else if (prompt) { lim = qpos | 63; lim_min = (qpos0 + wq) | 63; lim_max = lim_min; }
  else { lim = 2079; lim_min = 2079; lim_max = 2079; }
  const int nt_w = wvalid ? (lim_max >> 6) + 1 : 0;
  const int nt_b = prompt ? 2 * qb + 2 : 33;
  const float sc = (FOX ? 0.125f : 0.10206207261596577f) * LOG2E;

  bf16x8 qf[NKS];
  {
    const u16* qp = Q + (size_t)qtok * ldq + h * DK + hh * 8;
#pragma unroll
    for (int ks = 0; ks < NKS; ks++) qf[ks] = *(const bf16x8*)(qp + ks * 16);
    if (!FOX) {
      const float* ct = (const float*)(ws + OFF_COS) + qpos * 16 + hh * 8;
      const float* st = (const float*)(ws + OFF_SIN) + qpos * 16 + hh * 8;
#pragma unroll
      for (int j = 0; j < 8; j++) {
        float x1 = bf2f((u16)qf[NKS - 2][j]), x2 = bf2f((u16)qf[NKS - 1][j]);
        float c = ct[j], s = st[j];
        qf[NKS - 2][j] = (short)f2bf(x1 * c - x2 * s);
        qf[NKS - 1][j] = (short)f2bf(x1 * s + x2 * c);
      }
    }
  }
  float ci = 0.f;
  if (FOX) ci = c2[((size_t)rowbase + qpos) * 8 + h];

  f32x16 oacc[2];
#pragma unroll
  for (int i = 0; i < 2; i++)
#pragma unroll
    for (int r = 0; r < 16; r++) oacc[i][r] = 0.f;
  float m_i = -1e30f, l_i = 0.f;

  uint4 kreg[NKL], vreg[2];
  float creg = 0.f;
  auto load_tile = [&](int t) {
    const int key0 = t * 64;
#pragma unroll
    for (int i = 0; i < NKL; i++) {
      int c = tid + i * 256;
      int key = c / NKC, kc = c % NKC;
      int kk = key0 + key;
      uint4 v = {0, 0, 0, 0};
      if (kk < len) {
        size_t row = (size_t)rowbase + kk;
        if (FOX || kc < 8) v = *(const uint4*)(Kb + row * 512 + h * 64 + kc * 8);
        else v = *(const uint4*)(kpeb + row * 32 + (kc - 8) * 8);
      }
      kreg[i] = v;
    }
#pragma unroll
    for (int i = 0; i < 2; i++) {
      int c = tid + i * 256;
      int d = c >> 3, kc = c & 7;
      uint4 v = {0, 0, 0, 0};
      if (key0 + kc * 8 < len)
        v = *(const uint4*)(Vt + (size_t)rowbase * 512 + (size_t)(h * 64 + d) * len + key0 + kc * 8);
      vreg[i] = v;
    }
    if (FOX) {
      if (tid < 64) {
        int kk = key0 + tid;
        creg = kk < len ? c2[((size_t)rowbase + kk) * 8 + h] : 0.f;
      }
    }
  };
  load_tile(0);

  for (int t = 0; t < nt_b; t++) {
    __syncthreads();
#pragma unroll
    for (int i = 0; i < NKL; i++) {
      int c = tid + i * 256;
      int key = c / NKC, kc = c % NKC;
      *(uint4*)&sK[key * KS + kc * 8] = kreg[i];
    }
#pragma unroll
    for (int i = 0; i < 2; i++) {
      int c = tid + i * 256;
      int d = c >> 3, kc = c & 7;
      uint2 lo = {vreg[i].x, vreg[i].y}, hi = {vreg[i].z, vreg[i].w};
      *(uint2*)&sV[d * VS + kc * 8] = lo;
      *(uint2*)&sV[d * VS + kc * 8 + 4] = hi;
    }
    if (FOX) {
      if (tid < 64) sC[tid] = creg;
    }
    __syncthreads();
    if (t + 1 < nt_b) load_tile(t + 1);
    if (t < nt_w) {
      f32x16 sacc[2];
#pragma unroll
      for (int i = 0; i < 2; i++)
#pragma unroll
        for (int r = 0; r < 16; r++) sacc[i][r] = 0.f;
#pragma unroll
      for (int ks = 0; ks < NKS; ks++) {
#pragma unroll
        for (int mb = 0; mb < 2; mb++) {
          bf16x8 kf = *(const bf16x8*)&sK[(mb * 32 + l31) * KS + ks * 16 + hh * 8];
          sacc[mb] = __builtin_amdgcn_mfma_f32_32x32x16_bf16(kf, qf[ks], sacc[mb], 0, 0, 0);
        }
      }
      const int key0 = t * 64;
      const bool need_mask = (key0 + 63 > lim_min);
      float mx = -1e30f;
#pragma unroll
      for (int mb = 0; mb < 2; mb++)
#pragma unroll
        for (int g = 0; g < 4; g++) {
          float4 cj = {0.f, 0.f, 0.f, 0.f};
          if (FOX) cj = *(const float4*)&sC[mb * 32 + 8 * g + 4 * hh];
          const float cja[4] = {cj.x, cj.y, cj.z, cj.w};
#pragma unroll
          for (int j = 0; j < 4; j++) {
            float v = sacc[mb][4 * g + j] * sc;
            if (FOX) v += ci - cja[j];
            if (need_mask) {
              int key = key0 + mb * 32 + 8 * g + 4 * hh + j;
              if (key > lim) v = -1e30f;
            }
            sacc[mb][4 * g + j] = v;
            mx = fmaxf(mx, v);
          }
        }
      mx = fmaxf(mx, __shfl_xor(mx, 32));
      const float m_new = fmaxf(m_i, mx);
      const float alpha = fast_exp2(m_i - m_new);
      m_i = m_new;
      float ps = 0.f;
#pragma unroll
      for (int mb = 0; mb < 2; mb++)
#pragma unroll
        for (int r = 0; r < 16; r++) {
          float pv = fast_exp2(sacc[mb][r] - m_new);
          sacc[mb][r] = pv;
          ps += pv;
        }
      l_i = l_i * alpha + ps;
#pragma unroll
      for (int db = 0; db < 2; db++)
#pragma unroll
        for (int r = 0; r < 16; r++) oacc[db][r] *= alpha;
#pragma unroll
      for (int mb = 0; mb < 2; mb++)
#pragma unroll
        for (int s = 0; s < 2; s++) {
          union { unsigned u[4]; bf16x8 v; } pf;
#pragma unroll
          for (int j = 0; j < 4; j++) pf.u[j] = pack2(sacc[mb][8 * s + 2 * j], sacc[mb][8 * s + 2 * j + 1]);
#pragma unroll
          for (int db = 0; db < 2; db++) {
            const u16* vp = &sV[(db * 32 + l31) * VS + mb * 32 + s * 16 + 4 * hh];
            uint2 lo = *(const uint2*)vp, hi = *(const uint2*)(vp + 8);
            union { unsigned u[4]; bf16x8 v; } vf;
            vf.u[0] = lo.x; vf.u[1] = lo.y; vf.u[2] = hi.x; vf.u[3] = hi.y;
            oacc[db] = __builtin_amdgcn_mfma_f32_32x32x16_bf16(vf.v, pf.v, oacc[db], 0, 0, 0);
          }
        }
    }
  }
  l_i += __shfl_xor(l_i, 32);
  if (wvalid) {
    const float inv = 1.f / l_i;
    float* op = O + (size_t)qtok * 512 + h * 64;
#pragma unroll
    for (int db = 0; db < 2; db++)
#pragma unroll
      for (int g = 0; g < 4; g++) {
        float4 o = {oacc[db][4 * g] * inv, oacc[db][4 * g + 1] * inv, oacc[db][4 * g + 2] * inv,
                    oacc[db][4 * g + 3] * inv};
        *(float4*)(op + db * 32 + 8 * g + 4 * hh) = o;
      }
  }
  __syncthreads();
}

__device__ void phase_attn(const P& p, char* smem) {
  for (int idx = blockIdx.x; idx < 4608; idx += gridDim.x) {
    int type, seq, h, qb;
    if (idx < 3008) {
      qb = 63 - (idx >> 6);
      int sub = idx & 63;
      type = sub >> 5; seq = (sub >> 3) & 3; h = sub & 7;
    } else if (idx < 3520) {
      int j = idx - 3008;
      type = j >> 8; seq = 4 + ((j >> 3) & 31); h = j & 7; qb = 0;
    } else {
      int j = idx - 3520;
      qb = 16 - (j >> 6);
      int sub = j & 63;
      type = sub >> 5; seq = (sub >> 3) & 3; h = sub & 7;
    }
    if (type == 0) attn_item<96, false>(p, seq, h, qb, smem);
    else attn_item<64, true>(p, seq, h, qb, smem);
  }
}

__device__ void phase_r3(const P& p) {
  const int lane = threadIdx.x & 63, w = threadIdx.x >> 6;
  u16* cat = (u16*)(p.ws + OFF_ACT1);
  for (int r = blockIdx.x * 4 + w; r < T_ALL; r += gridDim.x * 4) {
#pragma unroll
    for (int part = 0; part < 2; part++) {
      const float* o = p.out + (size_t)part * T_ALL * 512 + (size_t)r * 512;
      const float* g = part ? p.g_mla_out : p.g_fox_out;
      float4 a = *(const float4*)(o + lane * 4), b = *(const float4*)(o + 256 + lane * 4);
      float ss = a.x * a.x + a.y * a.y + a.z * a.z + a.w * a.w + b.x * b.x + b.y * b.y + b.z * b.z + b.w * b.w;
      ss = wave_sum(ss);
      float rs = rsqrtf(ss * (1.f / 512.f) + EPSN);
      float4 ga = *(const float4*)(g + lane * 4), gb = *(const float4*)(g + 256 + lane * 4);
      uint2 oa = {pack2(a.x * rs * ga.x, a.y * rs * ga.y), pack2(a.z * rs * ga.z, a.w * rs * ga.w)};
      uint2 ob = {pack2(b.x * rs * gb.x, b.y * rs * gb.y), pack2(b.z * rs * gb.z, b.w * rs * gb.w)};
      *(uint2*)(cat + (size_t)r * 1024 + part * 512 + lane * 4) = oa;
      *(uint2*)(cat + (size_t)r * 1024 + part * 512 + 256 + lane * 4) = ob;
    }
  }
}

template <int MODE>
__device__ void phase_rn(const P& p) {
  const int lane = threadIdx.x & 63, w = threadIdx.x >> 6;
  char* ws = p.ws;
  const float* src = (const float*)(ws + (MODE == 1 ? OFF_D : OFF_MIX));
  const float* g1 = MODE == 0 ? p.g_post_mix : (MODE == 1 ? p.g_post_mlp : p.g_ple_post);
  const float* g2 = MODE == 0 ? p.g_pre_mlp : p.g_ple;
  u16* nxt = (u16*)(ws + OFF_ACT1);
  u16* pl = (u16*)(ws + OFF_PL);
  for (int r = blockIdx.x * 4 + w; r < T_ALL; r += gridDim.x * 4) {
    const float* s = src + (size_t)r * 1024;
    float* hy = p.out + (size_t)r * 1024;
    const float* base = MODE == 0 ? (r < T_P ? p.x_p + (size_t)r * 1024 : p.x_s + (size_t)(r - T_P) * 1024) : hy;
    float4 v[4];
    float ss = 0.f;
#pragma unroll
    for (int i = 0; i < 4; i++) {
      v[i] = *(const float4*)(s + i * 256 + lane * 4);
      ss += v[i].x * v[i].x + v[i].y * v[i].y + v[i].z * v[i].z + v[i].w * v[i].w;
    }
    ss = wave_sum(ss);
    float rs = rsqrtf(ss * (1.f / 1024.f) + EPSN);
    float ss2 = 0.f;
#pragma unroll
    for (int i = 0; i < 4; i++) {
      float4 g = *(const float4*)(g1 + i * 256 + lane * 4);
      float4 b = *(const float4*)(base + i * 256 + lane * 4);
      v[i].x = b.x + v[i].x * rs * g.x;
      v[i].y = b.y + v[i].y * rs * g.y;
      v[i].z = b.z + v[i].z * rs * g.z;
      v[i].w = b.w + v[i].w * rs * g.w;
      ss2 += v[i].x * v[i].x + v[i].y * v[i].y + v[i].z * v[i].z + v[i].w * v[i].w;
      *(float4*)(hy + i * 256 + lane * 4) = v[i];
    }
    if (MODE != 2) {
      ss2 = wave_sum(ss2);
      float rs2 = rsqrtf(ss2 * (1.f / 1024.f) + EPSN);
#pragma unroll
      for (int i = 0; i < 4; i++) {
        float4 g = *(const float4*)(g2 + i * 256 + lane * 4);
        uint2 o = {pack2(v[i].x * rs2 * g.x, v[i].y * rs2 * g.y), pack2(v[i].z * rs2 * g.z, v[i].w * rs2 * g.w)};
        *(uint2*)(nxt + (size_t)r * 1024 + i * 256 + lane * 4) = o;
      }
    }
    if (MODE == 1) {
      const float* pp = r < T_P ? p.p_p + (size_t)r * 256 : p.p_s + (size_t)(r - T_P) * 256;
      float4 a = *(const float4*)(pp + lane * 4);
      uint2 o = {pack2(a.x, a.y), pack2(a.z, a.w)};
      *(uint2*)(pl + (size_t)r * 256 + lane * 4) = o;
    }
  }
}

#define NPHASE 13
__global__ void __launch_bounds__(256, 2) mega(P p, int ph_lo, int ph_hi) {
  __shared__ __attribute__((aligned(16))) char smem[36864];
  cg::grid_group grid = cg::this_grid();
  char* ws = p.ws;
  __shared__ uint4 xb_words;
  if (threadIdx.x == 0) xb_words = make_uint4(0u, 0u, 0u, 0u);
  __syncthreads();
  XcdBarrier xb = xcd_barrier_post((unsigned*)(ws + OFF_BAR), (volatile LAS unsigned*)&xb_words);
  if (ph_lo <= 0 && 0 < ph_hi) {
    for (int rep_ = 0; rep_ < 1 + ((REPEAT >> 0) & 1); rep_++) {
 phase0(p, smem);
    }
    if (0 + 1 < ph_hi) { if (0 == 0) grid.sync(); else xcd_barrier(xb); }
  }
  if (ph_lo <= 1 && 1 < ph_hi) {
    for (int rep_ = 0; rep_ < 1 + ((REPEAT >> 1) & 1); rep_++) {
        for (int t = blockIdx.x; t < 264 * 18; t += gridDim.x)
          gemm_tile<EPI_IN>(p, (const u16*)(ws + OFF_ACT1), 1024, (const u16*)(ws + OFF_WIN), 1024, (t / 18) * 128,
                            (t % 18) * 128, nullptr, 0, smem);
    }
    if (1 + 1 < ph_hi) { if (1 == 0) grid.sync(); else xcd_barrier(xb); }
  }
  if (ph_lo <= 2 && 2 < ph_hi) {
    for (int rep_ = 0; rep_ < 1 + ((REPEAT >> 2) & 1); rep_++) {
 phase_r2(p);
    }
    if (2 + 1 < ph_hi) { if (2 == 0) grid.sync(); else xcd_barrier(xb); }
  }
  if (ph_lo <= 3 && 3 < ph_hi) {
    for (int rep_ = 0; rep_ < 1 + ((REPEAT >> 3) & 1); rep_++) {
 {
        for (int t = blockIdx.x; t < 36 + 1584 + 6208; t += gridDim.x) {
          if (t < 36) scan_seq(p, t, smem);
          else if (t < 36 + 1584) {
            int j = t - 36;
            gemm_tile<EPI_BF16>(p, (const u16*)p.out, 384, (const u16*)(ws + OFF_WQ), 384, (j / 6) * 128,
                                (j % 6) * 128, ws + OFF_ACT1, 768, smem);
          } else {
            int j = t - 36 - 1584;
            gemm_tile<EPI_KV>(p, (const u16*)((char*)p.out + (size_t)T_ALL * 384 * 2), 256,
                              (const u16*)(ws + OFF_WKV), 256, (j >> 3) * 128, (j & 7) * 128, nullptr, 0, smem);
          }
        }
      }
    }
    if (3 + 1 < ph_hi) { if (3 == 0) grid.sync(); else xcd_barrier(xb); }
  }
  if (ph_lo <= 4 && 4 < ph_hi) {
    for (int rep_ = 0; rep_ < 1 + ((REPEAT >> 4) & 1); rep_++) {
 phase_attn(p, smem);
    }
    if (4 + 1 < ph_hi) { if (4 == 0) grid.sync(); else xcd_barrier(xb); }
  }
  if (ph_lo <= 5 && 5 < ph_hi) {
    for (int rep_ = 0; rep_ < 1 + ((REPEAT >> 5) & 1); rep_++) {
 phase_r3(p);
    }
    if (5 + 1 < ph_hi) { if (5 == 0) grid.sync(); else xcd_barrier(xb); }
  }
  if (ph_lo <= 6 && 6 < ph_hi) {
    for (int rep_ = 0; rep_ < 1 + ((REPEAT >> 6) & 1); rep_++) {

        for (int t = blockIdx.x; t < 264 * 8; t += gridDim.x)
          gemm_tile<EPI_F32>(p, (const u16*)(ws + OFF_ACT1), 1024, (const u16*)(ws + OFF_WO), 1024, (t >> 3) * 128,
                             (t & 7) * 128, ws + OFF_MIX, 1024, smem);
    }
    if (6 + 1 < ph_hi) { if (6 == 0) grid.sync(); else xcd_barrier(xb); }
  }
  if (ph_lo <= 7 && 7 < ph_hi) {
    for (int rep_ = 0; rep_ < 1 + ((REPEAT >> 7) & 1); rep_++) {
 phase_rn<0>(p);
    }
    if (7 + 1 < ph_hi) { if (7 == 0) grid.sync(); else xcd_barrier(xb); }
  }
  if (ph_lo <= 8 && 8 < ph_hi) {
    for (int rep_ = 0; rep_ < 1 + ((REPEAT >> 8) & 1); rep_++) {

        for (int t = blockIdx.x; t < 264 * 32; t += gridDim.x)
          gemm_tile<EPI_RELU2>(p, (const u16*)(ws + OFF_ACT1), 1024, (const u16*)(ws + OFF_WUP), 1024,
                               (t >> 5) * 128, (t & 31) * 128, ws + OFF_ACT, 4096, smem);
    }
    if (8 + 1 < ph_hi) { if (8 == 0) grid.sync(); else xcd_barrier(xb); }
  }
  if (ph_lo <= 9 && 9 < ph_hi) {
    for (int rep_ = 0; rep_ < 1 + ((REPEAT >> 9) & 1); rep_++) {

        for (int t = blockIdx.x; t < 264 * 8; t += gridDim.x)
          gemm_tile<EPI_F32>(p, (const u16*)(ws + OFF_ACT), 4096, (const u16*)(ws + OFF_WDN), 4096, (t >> 3) * 128,
                             (t & 7) * 128, ws + OFF_D, 1024, smem);
    }
    if (9 + 1 < ph_hi) { if (9 == 0) grid.sync(); else xcd_barrier(xb); }
  }
  if (ph_lo <= 10 && 10 < ph_hi) {
    for (int rep_ = 0; rep_ < 1 + ((REPEAT >> 10) & 1); rep_++) {
 phase_rn<1>(p);
    }
    if (10 + 1 < ph_hi) { if (10 == 0) grid.sync(); else xcd_barrier(xb); }
  }
  if (ph_lo <= 11 && 11 < ph_hi) {
    for (int rep_ = 0; rep_ < 1 + ((REPEAT >> 11) & 1); rep_++) {

        for (int t = blockIdx.x; t < 264 * 8; t += gridDim.x) {
          gemm_tile<EPI_GATE>(p, (const u16*)(ws + OFF_ACT1), 1024, (const u16*)(ws + OFF_WG), 1024, (t >> 3) * 128,
                              (t & 7) * 128, ws + OFF_MIX, 1024, smem);
          gemm_tile<EPI_PROD>(p, (const u16*)(ws + OFF_PL), 256, (const u16*)(ws + OFF_WPJ), 256, (t >> 3) * 128,
                              (t & 7) * 128, ws + OFF_MIX, 1024, smem);
        }
    }
    if (11 + 1 < ph_hi) { if (11 == 0) grid.sync(); else xcd_barrier(xb); }
  }
  if (ph_lo <= 12 && 12 < ph_hi) {
    for (int rep_ = 0; rep_ < 1 + ((REPEAT >> 12) & 1); rep_++) {
 phase_rn<2>(p);
    }
    if (12 + 1 < ph_hi) { if (12 == 0) grid.sync(); else xcd_barrier(xb); }
  }
}

extern "C" void kernel_launch(void* const* d_in, const int* in_sizes, int n_in, void* d_out, int out_size,
                              void* d_ws, size_t ws_size, hipStream_t stream) {
  static int grid_blocks = 0;
  if (!grid_blocks) {
    int dev = 0, cus = 0, per_cu = 0;
    hipGetDevice(&dev);
    hipDeviceGetAttribute(&cus, hipDeviceAttributeMultiprocessorCount, dev);
    hipOccupancyMaxActiveBlocksPerMultiprocessor(&per_cu, mega, 256, 0);
    if (per_cu < 1) per_cu = 1;
    if (per_cu > 2) per_cu = 2;
    grid_blocks = cus * per_cu;
  }
  if (ws_size < OFF_END + 65536) {
    fprintf(stderr, "workspace too small: %zu < %zu\n", ws_size, (size_t)OFF_END);
    return;
  }
  P p{};
  const float** f = (const float**)&p;
  for (int i = 0; i < 28; i++) f[i] = (const float*)d_in[i];
  p.out = (float*)d_out;
  p.ws = (char*)d_ws;
  hipMemsetAsync((char*)d_ws + OFF_BAR, 0, XCD_BAR_WORDS * 4, stream);
#if COOP
  int lo = 0, hi = NPHASE;
  void* args[] = {&p, &lo, &hi};
  hipError_t e = hipLaunchCooperativeKernel((void*)mega, dim3(grid_blocks), dim3(256), args, 0, stream);
  if (e != hipSuccess) fprintf(stderr, "cooperative launch failed: %s (grid %d)\n", hipGetErrorString(e), grid_blocks);
#else
  for (int ph = 0; ph < NPHASE; ph++) mega<<<grid_blocks, 256, 0, stream>>>(p, ph, ph + 1);
#endif
}
```

```cpp
#include <hip/hip_runtime.h>
#include <hip/hip_cooperative_groups.h>
#include <cstdio>
namespace cg = cooperative_groups;

typedef unsigned short u16;
using bf16x8 = __attribute__((ext_vector_type(8))) short;
using f32x16 = __attribute__((ext_vector_type(16))) float;
using u32x4 = __attribute__((ext_vector_type(4))) unsigned;

#define T_P 32768
#define T_ALL 33792
#define U_ALL 99328
#define USL (U_ALL + 64)
#define LOG2E 1.4426950408889634f
#define EPSN 1e-6f

#ifndef COOP
#define COOP 1
#endif
#ifndef REPEAT
#define REPEAT 0
#endif

constexpr size_t SZ_WIN = 2304ull * 1024 * 2, SZ_WQ = 768ull * 384 * 2, SZ_WKV = 1024ull * 256 * 2,
                 SZ_WO = 1024ull * 1024 * 2, SZ_WUP = 4096ull * 1024 * 2, SZ_WDN = 1024ull * 4096 * 2,
                 SZ_WG = 1024ull * 1024 * 2, SZ_WPJ = 1024ull * 256 * 2, SZ_ROPE = 8192ull * 16 * 4;
constexpr size_t OFF_WIN = 0, OFF_WQ = OFF_WIN + SZ_WIN, OFF_WKV = OFF_WQ + SZ_WQ, OFF_WO = OFF_WKV + SZ_WKV,
                 OFF_WUP = OFF_WO + SZ_WO, OFF_WDN = OFF_WUP + SZ_WUP, OFF_WG = OFF_WDN + SZ_WDN,
                 OFF_WPJ = OFF_WG + SZ_WG, OFF_COS = OFF_WPJ + SZ_WPJ, OFF_SIN = OFF_COS + SZ_ROPE,
                 OFF_ACT1 = OFF_SIN + SZ_ROPE;
constexpr size_t SZ_ACT1 = (size_t)T_ALL * 1024 * 2;
constexpr size_t OFF_POOL = OFF_ACT1 + SZ_ACT1;
constexpr size_t OFF_QF = OFF_POOL, SZ_QF = (size_t)T_ALL * 512 * 2;
constexpr size_t OFF_KPE = OFF_QF + SZ_QF, SZ_KPE = (size_t)USL * 32 * 2;
constexpr size_t OFF_LOGF = OFF_KPE + SZ_KPE, SZ_LOGF = (size_t)USL * 8 * 4;
constexpr size_t OFF_C2 = OFF_LOGF + SZ_LOGF;
constexpr size_t OFF_KF = OFF_C2 + SZ_LOGF, SZ_KF = (size_t)USL * 512 * 2;
constexpr size_t OFF_VTF = OFF_KF + SZ_KF;
constexpr size_t OFF_KN = OFF_VTF + SZ_KF;
constexpr size_t OFF_ZV = OFF_KN + SZ_KF;
constexpr size_t SZ_ZV = (size_t)T_ALL * 768 * 4;
constexpr size_t OFF_END = OFF_ZV + SZ_ZV;
constexpr size_t OFF_BAR = OFF_END + 4096;
constexpr size_t OFF_CTR = OFF_BAR + 3456 * 4 + 256;
constexpr size_t OFF_KMAX = OFF_CTR + 256;
constexpr size_t SZ_SYNC = 3456 * 4 + 256 + 256 + 36 * 8 * 4 + 256;
constexpr size_t OFF_MIX = OFF_POOL;
constexpr size_t OFF_ACT = OFF_POOL;
constexpr size_t OFF_D = OFF_POOL + (size_t)T_ALL * 4096 * 2;
constexpr size_t OFF_PL = OFF_D + (size_t)T_ALL * 1024 * 4;
static_assert(OFF_PL + (size_t)T_ALL * 256 * 2 <= OFF_END, "pool too small");
static_assert((size_t)USL * 512 * 2 <= SZ_ZV, "zv");

constexpr size_t O_Y = 0, O_FKP = 34603008ull, O_FVP = 51380224ull, O_LFP = 68157440ull, O_CKVP = 68419584ull,
                 O_KPEP = 76808192ull, O_FKS = 77856768ull, O_FVS = 78381056ull, O_LFS = 78905344ull,
                 O_CKVS = 78913536ull, O_KPES = 79175680ull;

struct P {
  const float *x_p, *x_s, *p_p, *p_s, *c_fk, *c_fv, *c_lf, *c_ckv, *c_kpe;
  const float *g_pre_mix, *w_in, *b_fox_f, *g_mla_q, *w_q_up, *g_mla_kv, *w_kv_up, *g_fox_out, *g_mla_out, *w_out,
      *g_post_mix, *g_pre_mlp, *w_up, *w_down, *g_post_mlp, *g_ple, *w_gate, *w_proj, *g_ple_post;
  float* out;
  char* ws;
};

__device__ __forceinline__ u16 f2bf(float f) {
  unsigned u = __float_as_uint(f);
  u += 0x7fffu + ((u >> 16) & 1u);
  return (u16)(u >> 16);
}
__device__ __forceinline__ float bf2f(u16 v) { return __uint_as_float(((unsigned)v) << 16); }
__device__ __forceinline__ unsigned pack2(float a, float b) {
  unsigned r;
  asm("v_cvt_pk_bf16_f32 %0, %1, %2" : "=v"(r) : "v"(a), "v"(b));
  return r;
}
__device__ __forceinline__ float sq_bf2(unsigned u) {
  float a = __uint_as_float(u << 16), b = __uint_as_float(u & 0xffff0000u);
  return a * a + b * b;
}
__device__ __forceinline__ float wave_sum(float v) {
#pragma unroll
  for (int o = 32; o > 0; o >>= 1) v += __shfl_xor(v, o);
  return v;
}
__device__ __forceinline__ int urow(int r) {
  return r < T_P ? r : T_P + ((r - T_P) >> 5) * 2080 + 2048 + ((r - T_P) & 31);
}
__device__ __forceinline__ float fast_exp2(float x) { return __builtin_amdgcn_exp2f(x); }


#define XB_TMO      128
#define XB_XCNT(j)  (256  + 64 * (j))
#define XB_XSUB(j)  (1280 + 64 * (j))
#define XB_XGEN(j)  (2304 + 64 * (j))
#define XB_TOP      3328
#define XB_TOPGEN   3392
#define XCD_BAR_WORDS 3456
#define XB_SPIN_CAP (1u << 22)
#define LAS __attribute__((address_space(3)))
__device__ __forceinline__ unsigned xb_ld(unsigned* p) { return __hip_atomic_load(p, __ATOMIC_RELAXED, __HIP_MEMORY_SCOPE_AGENT); }
__device__ __forceinline__ unsigned xb_add(unsigned* p, unsigned v) { return __hip_atomic_fetch_add(p, v, __ATOMIC_RELAXED, __HIP_MEMORY_SCOPE_AGENT); }
__device__ __forceinline__ unsigned xb_xcc_id() { return (unsigned)__builtin_amdgcn_s_getreg((3 << 11) | 20) & 0xFu; }
#define XB_SPIN(cond, bar) do { unsigned _sp = 0; while (cond) { __builtin_amdgcn_s_sleep(1); \
    if ((++_sp & 255u) == 0u) { if (xb_ld(&(bar)[XB_TMO])) break; if (_sp > XB_SPIN_CAP) { atomicAdd(&(bar)[XB_TMO], 1u); break; } } } } while (0)
struct XcdBarrier { unsigned* bar; unsigned x; volatile LAS unsigned* st; };
__device__ __forceinline__ XcdBarrier xcd_barrier_post(unsigned* bar, volatile LAS unsigned* st) {
  XcdBarrier b; b.bar = bar; b.x = xb_xcc_id(); b.st = st;
  if (threadIdx.x == 0) (void)xb_add(&bar[XB_XCNT(b.x)], 1u);
  return b;
}
__device__ __forceinline__ void xcd_barrier_complete(unsigned* bar, unsigned x, unsigned& nloc, unsigned& nx) {
  const unsigned G = gridDim.x * gridDim.y * gridDim.z;
  unsigned sum, cnt, mine, sp = 0u;
  for (;;) {
    sum = 0u; cnt = 0u; mine = 0u;
#pragma unroll
    for (unsigned j = 0; j < 16; ++j) { const unsigned c = xb_ld(&bar[XB_XCNT(j)]); sum += c; cnt += (c > 0u) ? 1u : 0u; mine = (j == x) ? c : mine; }
    if (sum == G) break;
    __builtin_amdgcn_s_sleep(1);
    if ((++sp & 255u) == 0u) { if (xb_ld(&bar[XB_TMO])) break; if (sp > XB_SPIN_CAP) { atomicAdd(&bar[XB_TMO], 1u); break; } }
  }
  nloc = mine > 0u ? mine : 1u; nx = cnt > 0u ? cnt : 1u;
}
__device__ __forceinline__ void xcd_barrier(const XcdBarrier& b) {
  asm volatile("s_waitcnt vmcnt(0)" ::: "memory");
  __syncthreads();
  if (threadIdx.x == 0) {
    unsigned* bar = b.bar;
    __builtin_amdgcn_s_waitcnt(0);
    unsigned nloc = b.st[0], nx = b.st[1];
    if (nloc == 0u) { xcd_barrier_complete(bar, b.x, nloc, nx); b.st[0] = nloc; b.st[1] = nx; }
    const unsigned old = xb_add(&bar[XB_XSUB(b.x)], 1u);
    const unsigned gen = old / nloc;
    if (old + 1u == (gen + 1u) * nloc) {
      __builtin_amdgcn_fence(__ATOMIC_RELEASE, "agent");
      asm volatile("s_waitcnt vmcnt(0)" ::: "memory");
      const unsigned og = xb_add(&bar[XB_TOP], 1u);
      const unsigned tg = og / nx;
      if (og + 1u == (tg + 1u) * nx) xb_add(&bar[XB_TOPGEN], 1u);
      else XB_SPIN(xb_ld(&bar[XB_TOPGEN]) == tg, bar);
      __builtin_amdgcn_fence(__ATOMIC_ACQUIRE, "agent");
      xb_add(&bar[XB_XGEN(b.x)], 1u);
      asm volatile("s_waitcnt vmcnt(0)" ::: "memory");
    } else {
      XB_SPIN(xb_ld(&bar[XB_XGEN(b.x)]) == gen, bar);
      __builtin_amdgcn_fence(__ATOMIC_ACQUIRE, "agent");
      asm volatile("s_waitcnt vmcnt(0)" ::: "memory");
    }
  }
  __syncthreads();
}

__device__ __forceinline__ int winmap(int c) {
  if (c < 1536) return c;
  if (c < 2208) return c + 8;
  if (c < 2216) return c - 672;
  return -1;
}

__device__ __forceinline__ void transpose_tile(const float* __restrict__ src, int ld_s, u16* __restrict__ dst,
                                               size_t ld_d, int r0, int c0, int mode, float* lds) {
  const int tx = threadIdx.x & 63, ty = threadIdx.x >> 6;
#pragma unroll 4
  for (int i = 0; i < 16; i++) {
    int r = i * 4 + ty;
    int c = c0 + tx;
    int cs = mode ? winmap(c) : c;
    float v = (cs >= 0) ? src[(size_t)(r0 + r) * ld_s + cs] : 0.f;
    lds[r * 65 + tx] = v;
  }
  __syncthreads();
#pragma unroll 4
  for (int i = 0; i < 16; i++) {
    int c = i * 4 + ty;
    dst[(size_t)(c0 + c) * ld_d + r0 + tx] = f2bf(lds[tx * 65 + c]);
  }
  __syncthreads();
}

__device__ void transpose_weight(const float* src, int K, int Nsrc, int Npad, u16* dst, int mode, float* lds) {
  const int nct = Npad / 64, nt = (K / 64) * nct;
  for (int t = blockIdx.x; t < nt; t += gridDim.x) {
    int rt = t / nct, ct = t % nct;
    transpose_tile(src, Nsrc, dst, (size_t)K, rt * 64, ct * 64, mode, lds);
  }
}

__constant__ float ROPE_INV[16] = {1.000000000e+00f, 5.623413324e-01f, 3.162277639e-01f, 1.778279394e-01f,
                                   1.000000015e-01f, 5.623413250e-02f, 3.162277490e-02f, 1.778279431e-02f,
                                   9.999999776e-03f, 5.623413250e-03f, 3.162277630e-03f, 1.778279431e-03f,
                                   1.000000047e-03f, 5.623413017e-04f, 3.162277571e-04f, 1.778279402e-04f};

__device__ void phase0(const P& p, char* smem) {
  char* ws = p.ws;
  float* lds = (float*)smem;
  transpose_weight(p.w_in, 1024, 2216, 2304, (u16*)(ws + OFF_WIN), 1, lds);
  transpose_weight(p.w_q_up, 384, 768, 768, (u16*)(ws + OFF_WQ), 0, lds);
  transpose_weight(p.w_kv_up, 256, 1024, 1024, (u16*)(ws + OFF_WKV), 0, lds);
  transpose_weight(p.w_out, 1024, 1024, 1024, (u16*)(ws + OFF_WO), 0, lds);
  transpose_weight(p.w_up, 1024, 4096, 4096, (u16*)(ws + OFF_WUP), 0, lds);
  transpose_weight(p.w_down, 4096, 1024, 1024, (u16*)(ws + OFF_WDN), 0, lds);
  transpose_weight(p.w_gate, 1024, 1024, 1024, (u16*)(ws + OFF_WG), 0, lds);
  transpose_weight(p.w_proj, 256, 1024, 1024, (u16*)(ws + OFF_WPJ), 0, lds);
  for (int it = blockIdx.x; it < 8192; it += gridDim.x) {
    int b = it >> 8, rt = (it >> 3) & 31, ct = it & 7;
    transpose_tile(p.c_fv + (size_t)b * 2048 * 512, 512, (u16*)(ws + OFF_VTF) + (size_t)(T_P + b * 2080) * 512,
                   (size_t)2080, rt * 64, ct * 64, 0, lds);
  }
  const size_t gtid = (size_t)blockIdx.x * 256 + threadIdx.x, gsz = (size_t)gridDim.x * 256;
  {
    float* cosT = (float*)(ws + OFF_COS);
    float* sinT = (float*)(ws + OFF_SIN);
    for (size_t i = gtid; i < 8192 * 16; i += gsz) {
      int pos = (int)(i >> 4), k = (int)(i & 15);
      float ang = (float)pos * ROPE_INV[k];
      cosT[i] = cosf(ang);
      sinT[i] = sinf(ang);
    }
  }
  {
    u16* Kf = (u16*)(ws + OFF_KF);
    for (size_t c = gtid; c < (size_t)65536 * 64; c += gsz) {
      size_t e = c * 8;
      int row = (int)(e >> 9), col = (int)(e & 511);
      int u = T_P + (row >> 11) * 2080 + (row & 2047);
      float4 a = *(const float4*)(p.c_fk + e), b = *(const float4*)(p.c_fk + e + 4);
      uint4 o = {pack2(a.x, a.y), pack2(a.z, a.w), pack2(b.x, b.y), pack2(b.z, b.w)};
      *(uint4*)(Kf + (size_t)u * 512 + col) = o;
      {
        float ss = sq_bf2(o.x) + sq_bf2(o.y) + sq_bf2(o.z) + sq_bf2(o.w);
        ss += __shfl_xor(ss, 1); ss += __shfl_xor(ss, 2); ss += __shfl_xor(ss, 4);
        unsigned* km = (unsigned*)(ws + OFF_KMAX) + (4 + (row >> 11)) * 8 + (col >> 6);
        if ((threadIdx.x & 7) == 0 && __float_as_uint(ss) > *km) atomicMax(km, __float_as_uint(ss));
      }
    }
  }
  {
    u16* ckvb = (u16*)((char*)p.out + (size_t)T_ALL * 384 * 2);
    for (size_t c = gtid; c < (size_t)65536 * 32; c += gsz) {
      size_t e = c * 8;
      int row = (int)(e >> 8), col = (int)(e & 255);
      int u = T_P + (row >> 11) * 2080 + (row & 2047);
      float4 a = *(const float4*)(p.c_ckv + e), b = *(const float4*)(p.c_ckv + e + 4);
      uint4 o = {pack2(a.x, a.y), pack2(a.z, a.w), pack2(b.x, b.y), pack2(b.z, b.w)};
      *(uint4*)(ckvb + (size_t)u * 256 + col) = o;
    }
  }
  {
    u16* kpeb = (u16*)(ws + OFF_KPE);
    for (size_t c = gtid; c < (size_t)65536 * 4; c += gsz) {
      size_t e = c * 8;
      int row = (int)(e >> 5), col = (int)(e & 31);
      int u = T_P + (row >> 11) * 2080 + (row & 2047);
      float4 a = *(const float4*)(p.c_kpe + e), b = *(const float4*)(p.c_kpe + e + 4);
      uint4 o = {pack2(a.x, a.y), pack2(a.z, a.w), pack2(b.x, b.y), pack2(b.z, b.w)};
      *(uint4*)(kpeb + (size_t)u * 32 + col) = o;
    }
  }
  {
    float* lw = (float*)(ws + OFF_LOGF);
    for (size_t c = gtid; c < (size_t)65536 * 2; c += gsz) {
      size_t e = c * 4;
      int row = (int)(e >> 3), col = (int)(e & 7);
      int u = T_P + (row >> 11) * 2080 + (row & 2047);
      *(float4*)(lw + (size_t)u * 8 + col) = *(const float4*)(p.c_lf + e);
    }
  }
  {
    const int lane = threadIdx.x & 63, w = threadIdx.x >> 6;
    u16* xn = (u16*)(ws + OFF_ACT1);
    for (int r = blockIdx.x * 4 + w; r < T_ALL; r += gridDim.x * 4) {
      const float* x = r < T_P ? p.x_p + (size_t)r * 1024 : p.x_s + (size_t)(r - T_P) * 1024;
      float4 v[4];
      float ss = 0.f;
#pragma unroll
      for (int i = 0; i < 4; i++) {
        v[i] = *(const float4*)(x + i * 256 + lane * 4);
        ss += v[i].x * v[i].x + v[i].y * v[i].y + v[i].z * v[i].z + v[i].w * v[i].w;
      }
      ss = wave_sum(ss);
      float rs = rsqrtf(ss * (1.f / 1024.f) + EPSN);
#pragma unroll
      for (int i = 0; i < 4; i++) {
        float4 g = *(const float4*)(p.g_pre_mix + i * 256 + lane * 4);
        uint2 o = {pack2(v[i].x * rs * g.x, v[i].y * rs * g.y), pack2(v[i].z * rs * g.z, v[i].w * rs * g.w)};
        *(uint2*)(xn + (size_t)r * 1024 + i * 256 + lane * 4) = o;
      }
    }
  }
}

enum { EPI_IN = 0, EPI_BF16 = 1, EPI_KV = 2, EPI_F32 = 3, EPI_RELU2 = 4, EPI_GATE = 5, EPI_PROD = 6 };

template <int EPI>
__device__ __forceinline__ void gemm_tile(const P& p, const u16* __restrict__ A, int lda,
                                          const u16* __restrict__ Bt, int K, int m0, int n0, void* Cptr, int ldc,
                                          char* smem) {
  u16* sA = (u16*)smem;
  u16* sB = sA + 128 * 72;
  const int tid = threadIdx.x, lane = tid & 63, w = tid >> 6, wm = w >> 1, wn = w & 1;
  const int l31 = lane & 31, hh = lane >> 5;
  f32x16 acc[2][2];
#pragma unroll
  for (int i = 0; i < 2; i++)
#pragma unroll
    for (int j = 0; j < 2; j++)
#pragma unroll
      for (int r = 0; r < 16; r++) acc[i][j][r] = 0.f;

  const int lr = tid >> 3, lc = (tid & 7) * 8;
  const u16* Ap = A + (size_t)(m0 + lr) * lda + lc;
  const u16* Bp = Bt + (size_t)(n0 + lr) * K + lc;
  u32x4 ra[4], rb[4];
  const int nk = K >> 6;
#pragma unroll
  for (int i = 0; i < 4; i++) {
    ra[i] = *(const u32x4*)(Ap + (size_t)i * 32 * lda);
    rb[i] = *(const u32x4*)(Bp + (size_t)i * 32 * K);
  }
#pragma unroll
  for (int i = 0; i < 4; i++) {
    *(u32x4*)&sA[(lr + i * 32) * 72 + lc] = ra[i];
    *(u32x4*)&sB[(lr + i * 32) * 72 + lc] = rb[i];
  }
  if (nk > 1) {
#pragma unroll
    for (int i = 0; i < 4; i++) {
      ra[i] = *(const u32x4*)(Ap + (size_t)i * 32 * lda + 64);
      rb[i] = *(const u32x4*)(Bp + (size_t)i * 32 * K + 64);
    }
  }
  for (int kt = 0; kt < nk; kt++) {
    __syncthreads();
    if (kt + 1 < nk) {
      u16* dA = sA + ((kt + 1) & 1) * (2 * 128 * 72);
      u16* dB = dA + 128 * 72;
#pragma unroll
      for (int i = 0; i < 4; i++) {
        *(u32x4*)&dA[(lr + i * 32) * 72 + lc] = ra[i];
        *(u32x4*)&dB[(lr + i * 32) * 72 + lc] = rb[i];
      }
      if (kt + 2 < nk) {
#pragma unroll
        for (int i = 0; i < 4; i++) {
          ra[i] = *(const u32x4*)(Ap + (size_t)i * 32 * lda + (kt + 2) * 64);
          rb[i] = *(const u32x4*)(Bp + (size_t)i * 32 * K + (kt + 2) * 64);
        }
      }
    }
    const u16* cA = sA + (kt & 1) * (2 * 128 * 72);
    const u16* cB = cA + 128 * 72;
#pragma unroll
    for (int ks = 0; ks < 4; ks++) {
      bf16x8 a0 = *(const bf16x8*)&cA[(wm * 64 + l31) * 72 + ks * 16 + hh * 8];
      bf16x8 a1 = *(const bf16x8*)&cA[(wm * 64 + 32 + l31) * 72 + ks * 16 + hh * 8];
      bf16x8 b0 = *(const bf16x8*)&cB[(wn * 64 + l31) * 72 + ks * 16 + hh * 8];
      bf16x8 b1 = *(const bf16x8*)&cB[(wn * 64 + 32 + l31) * 72 + ks * 16 + hh * 8];
      acc[0][0] = __builtin_amdgcn_mfma_f32_32x32x16_bf16(a0, b0, acc[0][0], 0, 0, 0);
      acc[0][1] = __builtin_amdgcn_mfma_f32_32x32x16_bf16(a0, b1, acc[0][1], 0, 0, 0);
      acc[1][0] = __builtin_amdgcn_mfma_f32_32x32x16_bf16(a1, b0, acc[1][0], 0, 0, 0);
      acc[1][1] = __builtin_amdgcn_mfma_f32_32x32x16_bf16(a1, b1, acc[1][1], 0, 0, 0);
    }
  }
  __syncthreads();

  char* ws = p.ws;
#pragma unroll
  for (int mi = 0; mi < 2; mi++)
#pragma unroll
    for (int ni = 0; ni < 2; ni++)
#pragma unroll
      for (int g = 0; g < 4; g++) {
        const int row = m0 + wm * 64 + mi * 32 + 8 * g + 4 * hh;
        const int col = n0 + wn * 64 + ni * 32 + l31;
        float v[4];
#pragma unroll
        for (int j = 0; j < 4; j++) v[j] = acc[mi][ni][4 * g + j];
        if (EPI == EPI_IN) {
          const int nt = n0 >> 7;
          if (nt < 4) {
            u16* Qf = (u16*)(ws + OFF_QF);
#pragma unroll
            for (int j = 0; j < 4; j++) Qf[(size_t)(row + j) * 512 + col] = f2bf(v[j]);
          } else if (nt < 8) {
            const int cc = col - 512;
            u16* Kf = (u16*)(ws + OFF_KF);
            float* o = row < T_P ? p.out + O_FKP + (size_t)row * 512 : p.out + O_FKS + (size_t)(row - T_P) * 512;
            const int u = urow(row);
#pragma unroll
            for (int j = 0; j < 4; j++) {
              o[(size_t)j * 512 + cc] = v[j];
              Kf[(size_t)(u + j) * 512 + cc] = f2bf(v[j]);
            }
          } else if (nt < 12) {
            const int cc = col - 1024;
            float* o = row < T_P ? p.out + O_FVP + (size_t)row * 512 : p.out + O_FVS + (size_t)(row - T_P) * 512;
#pragma unroll
            for (int j = 0; j < 4; j++) o[(size_t)j * 512 + cc] = v[j];
            size_t vbase;
            int pos, len;
            if (row < T_P) {
              vbase = (size_t)(row >> 13) * 8192 * 512; pos = row & 8191; len = 8192;
            } else {
              int rr = row - T_P;
              vbase = (size_t)(T_P + (rr >> 5) * 2080) * 512; pos = 2048 + (rr & 31); len = 2080;
            }
            u16* Vt = (u16*)(ws + OFF_VTF);
            uint2 pk = {pack2(v[0], v[1]), pack2(v[2], v[3])};
            *(uint2*)(Vt + vbase + (size_t)cc * len + pos) = pk;
          } else {
            float* zz = (float*)(ws + OFF_ZV);
#pragma unroll
            for (int j = 0; j < 4; j++) zz[(size_t)(row + j) * 768 + (col - 1536)] = v[j];
          }
        } else if (EPI == EPI_BF16) {
          u16* C = (u16*)Cptr;
#pragma unroll
          for (int j = 0; j < 4; j++) C[(size_t)(row + j) * ldc + col] = f2bf(v[j]);
        } else if (EPI == EPI_KV) {
          const int h = n0 >> 7;
          if (wn == 0) {
            u16* Kn = (u16*)(ws + OFF_KN);
            const int d = col - n0;
#pragma unroll
            for (int j = 0; j < 4; j++) Kn[(size_t)(row + j) * 512 + h * 64 + d] = f2bf(v[j]);
          } else {
            const int d = col - n0 - 64;
            size_t vbase;
            int pos, len;
            if (row < T_P) {
              vbase = (size_t)(row >> 13) * 8192 * 512; pos = row & 8191; len = 8192;
            } else {
              int rr = row - T_P;
              int b = rr / 2080;
              vbase = (size_t)(T_P + b * 2080) * 512; pos = rr - b * 2080; len = 2080;
            }
            u16* Vt = (u16*)(ws + OFF_ZV);
            uint2 pk = {pack2(v[0], v[1]), pack2(v[2], v[3])};
            *(uint2*)(Vt + vbase + (size_t)(h * 64 + d) * len + pos) = pk;
          }
        } else if (EPI == EPI_F32) {
          float* C = (float*)Cptr;
#pragma unroll
          for (int j = 0; j < 4; j++) C[(size_t)(row + j) * ldc + col] = v[j];
        } else if (EPI == EPI_RELU2) {
          u16* C = (u16*)Cptr;
#pragma unroll
          for (int j = 0; j < 4; j++) {
            float t = fmaxf(v[j], 0.f);
            C[(size_t)(row + j) * ldc + col] = f2bf(t * t);
          }
        } else if (EPI == EPI_GATE) {
          float* C = (float*)Cptr;
#pragma unroll
          for (int j = 0; j < 4; j++) C[(size_t)(row + j) * ldc + col] = 1.f / (1.f + __expf(-v[j]));
        } else if (EPI == EPI_PROD) {
          float* C = (float*)Cptr;
#pragma unroll
          for (int j = 0; j < 4; j++) {
            size_t a = (size_t)(row + j) * ldc + col;
            C[a] = C[a] * v[j];
          }
        }
      }
}

__device__ void phase_r2(const P& p) {
  char* ws = p.ws;
  const int lane = threadIdx.x & 63, w = threadIdx.x >> 6;
  const float* zz = (const float*)(ws + OFF_ZV);
  u16* qn = (u16*)p.out;
  u16* ckvb = (u16*)((char*)p.out + (size_t)T_ALL * 384 * 2);
  u16* kpeb = (u16*)(ws + OFF_KPE);
  float* lw = (float*)(ws + OFF_LOGF);
  const float* cosT = (const float*)(ws + OFF_COS);
  const float* sinT = (const float*)(ws + OFF_SIN);
  for (int r = blockIdx.x * 4 + w; r < T_ALL; r += gridDim.x * 4) {
    const float* z = zz + (size_t)r * 768;
    const int u = urow(r);
    const bool pr = r < T_P;
    const int rs_ = r - T_P;
    {
      float4 a = *(const float4*)(z + lane * 4);
      float2 b = *(const float2*)(z + 256 + lane * 2);
      float ss = a.x * a.x + a.y * a.y + a.z * a.z + a.w * a.w + b.x * b.x + b.y * b.y;
      ss = wave_sum(ss);
      float rs = rsqrtf(ss * (1.f / 384.f) + EPSN);
      float4 g = *(const float4*)(p.g_mla_q + lane * 4);
      float2 g2 = *(const float2*)(p.g_mla_q + 256 + lane * 2);
      uint2 o = {pack2(a.x * rs * g.x, a.y * rs * g.y), pack2(a.z * rs * g.z, a.w * rs * g.w)};
      *(uint2*)(qn + (size_t)r * 384 + lane * 4) = o;
      *(unsigned*)(qn + (size_t)r * 384 + 256 + lane * 2) = pack2(b.x * rs * g2.x, b.y * rs * g2.y);
    }
    {
      float4 a = *(const float4*)(z + 384 + lane * 4);
      float ss = a.x * a.x + a.y * a.y + a.z * a.z + a.w * a.w;
      ss = wave_sum(ss);
      float rs = rsqrtf(ss * (1.f / 256.f) + EPSN);
      float4 g = *(const float4*)(p.g_mla_kv + lane * 4);
      float4 o = {a.x * rs * g.x, a.y * rs * g.y, a.z * rs * g.z, a.w * rs * g.w};
      float* oc = pr ? p.out + O_CKVP + (size_t)r * 256 : p.out + O_CKVS + (size_t)rs_ * 256;
      *(float4*)(oc + lane * 4) = o;
      uint2 ob = {pack2(o.x, o.y), pack2(o.z, o.w)};
      *(uint2*)(ckvb + (size_t)u * 256 + lane * 4) = ob;
    }
    if (lane < 16) {
      const int pos = pr ? (r & 8191) : 2048 + (rs_ & 31);
      float x1 = z[640 + lane], x2 = z[656 + lane];
      float c = cosT[pos * 16 + lane], s = sinT[pos * 16 + lane];
      float o1 = x1 * c - x2 * s, o2 = x1 * s + x2 * c;
      float* ok = pr ? p.out + O_KPEP + (size_t)r * 32 : p.out + O_KPES + (size_t)rs_ * 32;
      ok[lane] = o1;
      ok[16 + lane] = o2;
      kpeb[(size_t)u * 32 + lane] = f2bf(o1);
      kpeb[(size_t)u * 32 + 16 + lane] = f2bf(o2);
    }
    {
      uint4 kk = *(const uint4*)((const u16*)(ws + OFF_KF) + (size_t)u * 512 + lane * 8);
      float ss = sq_bf2(kk.x) + sq_bf2(kk.y) + sq_bf2(kk.z) + sq_bf2(kk.w);
      ss += __shfl_xor(ss, 1); ss += __shfl_xor(ss, 2); ss += __shfl_xor(ss, 4);
      const int sid = pr ? (r >> 13) : 4 + (rs_ >> 5);
      unsigned* km = (unsigned*)(ws + OFF_KMAX) + sid * 8 + (lane >> 3);
      if ((lane & 7) == 0 && __float_as_uint(ss) > *km) atomicMax(km, __float_as_uint(ss));
    }
    if (lane < 8) {
      float x = z[672 + lane] + p.b_fox_f[lane];
      float lf = fminf(x, 0.f) - log1pf(expf(-fabsf(x)));
      float* ol = pr ? p.out + O_LFP + (size_t)r * 8 : p.out + O_LFS + (size_t)rs_ * 8;
      ol[lane] = lf;
      lw[(size_t)u * 8 + lane] = lf;
    }
  }
}

__device__ void scan_seq(const P& p, int seq, char* smem) {
  float* tot = (float*)smem;
  const float* lw = (const float*)(p.ws + OFF_LOGF);
  float* c2 = (float*)(p.ws + OFF_C2);
  const int tid = threadIdx.x, h = tid & 7, sg = tid >> 3;
  const int len = seq < 4 ? 8192 : 2080;
  const int rowbase = seq < 4 ? seq * 8192 : T_P + (seq - 4) * 2080;
  const int sl = len / 32;
  const size_t b0 = ((size_t)rowbase + (size_t)sg * sl) * 8 + h;
  float s = 0.f, mxl = -1.f;
#pragma unroll 8
  for (int i = 0; i < sl; i++) {
    float v = lw[b0 + (size_t)i * 8];
    s += v;
    mxl = fmaxf(mxl, v);
  }
  if (mxl > 0.f) atomicMax((unsigned*)(p.ws + OFF_KMAX) + seq * 8 + h, 0x7f800000u);
  tot[sg * 8 + h] = s;
  __syncthreads();
  float run = 0.f;
  for (int j = 0; j < sg; j++) run += tot[j * 8 + h];
#pragma unroll 8
  for (int i = 0; i < sl; i++) {
    run += lw[b0 + (size_t)i * 8];
    c2[b0 + (size_t)i * 8] = run * LOG2E;
  }
  __syncthreads();
}

template <int DK, bool FOX>
__device__ __forceinline__ void attn_item(const P& p, int seq, int h, int qb, char* smem) {
  constexpr int KS = DK + 8;
  constexpr int VS = 68;
  constexpr int NKS = DK / 16;
  constexpr int NKC = DK / 8;
  constexpr int NKL = (64 * NKC) / 256;
  constexpr int BUFB = 64 * KS * 2 + 64 * VS * 2 + 256;
  int* sFlag = (int*)(smem + 2 * BUFB);
  char* ws = p.ws;
  const int tid = threadIdx.x, lane = tid & 63, w = tid >> 6, l31 = lane & 31, hh = lane >> 5;

  const u16* Q = (const u16*)(ws + (FOX ? OFF_QF : OFF_ACT1));
  const int ldq = FOX ? 512 : 768;
  const u16* Kb = (const u16*)(ws + (FOX ? OFF_KF : OFF_KN));
  const u16* kpeb = (const u16*)(ws + OFF_KPE);
  const u16* Vt = (const u16*)(ws + (FOX ? OFF_VTF : OFF_ZV));
  const float* c2 = (const float*)(ws + OFF_C2);
  float* O = p.out + (FOX ? 0 : (size_t)T_ALL * 512);

  const bool prompt = seq < 4;
  const int len = prompt ? 8192 : 2080;
  const int rowbase = prompt ? seq * 8192 : T_P + (seq - 4) * 2080;
  const int qpos0 = prompt ? qb * 128 : 2048;
  const int qtok0 = prompt ? seq * 8192 + qb * 128 : T_P + (seq - 4) * 32;
  const bool wvalid = prompt || w == 0;
  const int wq = wvalid ? w * 32 : 0;
  const int qpos = qpos0 + wq + l31;
  const int qtok = qtok0 + wq + l31;
  int lim, lim_min, lim_max;
  if (FOX) { lim = qpos; lim_min = qpos0 + wq; lim_max = lim_min + 31; }
  else if (prompt) { lim = qpos | 63; lim_min = (qpos0 + wq) | 63; lim_max = lim_min; }
  else { lim = 2079; lim_min = 2079; lim_max = 2079; }
  const int nt_w = wvalid ? (lim_max >> 6) + 1 : 0;
  const int n = prompt ? 2 * qb + 2 : 33;
  const float sc = (FOX ? 0.125f : 0.10206207261596577f) * LOG2E;

  bf16x8 qf[NKS];
  float bound = 0.f;
  {
    const u16* qp = Q + (size_t)qtok * ldq + h * DK + hh * 8;
#pragma unroll
    for (int ks = 0; ks < NKS; ks++) qf[ks] = *(const bf16x8*)(qp + ks * 16);
    if (!FOX) {
      const float* ct = (const float*)(ws + OFF_COS) + qpos * 16 + hh * 8;
      const float* st = (const float*)(ws + OFF_SIN) + qpos * 16 + hh * 8;
#pragma unroll
      for (int j = 0; j < 8; j++) {
        float x1 = bf2f((u16)qf[NKS - 2][j]), x2 = bf2f((u16)qf[NKS - 1][j]);
        float c = ct[j], s = st[j];
        qf[NKS - 2][j] = (short)f2bf(x1 * c - x2 * s);
        qf[NKS - 1][j] = (short)f2bf(x1 * s + x2 * c);
      }
    }
  }
  float ci = 0.f;
  if (FOX) {
    ci = c2[((size_t)rowbase + qpos) * 8 + h];
    float ss = 0.f;
#pragma unroll
    for (int ks = 0; ks < NKS; ks++)
#pragma unroll
      for (int j = 0; j < 8; j++) { float x = bf2f((u16)qf[ks][j]); ss += x * x; }
    ss += __shfl_xor(ss, 32);
    const float kmax = sqrtf(__uint_as_float(((const unsigned*)(ws + OFF_KMAX))[seq * 8 + h]));
    bound = sqrtf(ss) * kmax * sc * 1.02f + 0.25f + ci;
  }

  f32x16 oacc[2];
#pragma unroll
  for (int i = 0; i < 2; i++)
#pragma unroll
    for (int r = 0; r < 16; r++) oacc[i][r] = 0.f;
  float m_i = -1e30f, l_i = 0.f;

  u32x4 kreg[NKL], vreg[2];
  float creg = 0.f;
  auto load_tile = [&](int t) {
    const int key0 = t * 64;
#pragma unroll
    for (int i = 0; i < NKL; i++) {
      int c = tid + i * 256;
      int key = c / NKC, kc = c % NKC;
      int kk = key0 + key;
      u32x4 v = {0u, 0u, 0u, 0u};
      if (kk < len) {
        size_t row = (size_t)rowbase + kk;
        if (FOX || kc < 8) v = *(const u32x4*)(Kb + row * 512 + h * 64 + kc * 8);
        else v = *(const u32x4*)(kpeb + row * 32 + (kc - 8) * 8);
      }
      kreg[i] = v;
    }
#pragma unroll
    for (int i = 0; i < 2; i++) {
      int c = tid + i * 256;
      int d = c >> 3, kc = c & 7;
      u32x4 v = {0u, 0u, 0u, 0u};
      if (key0 + kc * 8 < len)
        v = *(const u32x4*)(Vt + (size_t)rowbase * 512 + (size_t)(h * 64 + d) * len + key0 + kc * 8);
      vreg[i] = v;
    }
    if (FOX) {
      if (tid < 64) {
        int kk = key0 + tid;
        creg = kk < len ? c2[((size_t)rowbase + kk) * 8 + h] : 0.f;
      }
    }
  };
  auto store_tile = [&](int b) {
    u16* sK = (u16*)(smem + b * BUFB);
    u16* sV = sK + 64 * KS;
    float* sC = (float*)(sV + 64 * VS);
#pragma unroll
    for (int i = 0; i < NKL; i++) {
      int c = tid + i * 256;
      int key = c / NKC, kc = c % NKC;
      *(u32x4*)&sK[key * KS + kc * 8] = kreg[i];
    }
#pragma unroll
    for (int i = 0; i < 2; i++) {
      int c = tid + i * 256;
      int d = c >> 3, kc = c & 7;
      uint2 lo = {vreg[i].x, vreg[i].y}, hi = {vreg[i].z, vreg[i].w};
      *(uint2*)&sV[d * VS + kc * 8] = lo;
      *(uint2*)&sV[d * VS + kc * 8 + 4] = hi;
    }
    if (FOX) {
      if (tid < 64) sC[tid] = creg;
    }
  };

  load_tile(n - 1);
  store_tile(0);
  if (n > 1) load_tile(n - 2);
  if (tid < 8) sFlag[tid] = 0;
  bool wdone = !wvalid;

  for (int it = 0; it < n; it++) {
    const int t = n - 1 - it;
    __syncthreads();
    if (FOX) {
      const int* f = sFlag + (it & 1) * 4;
      if (f[0] & f[1] & f[2] & f[3]) break;
    }
    if (it + 1 < n) {
      store_tile((it + 1) & 1);
      if (it + 2 < n) load_tile(t - 2);
    }
    const u16* sK = (const u16*)(smem + (it & 1) * BUFB);
    const u16* sV = sK + 64 * KS;
    const float* sC = (const float*)(sV + 64 * VS);
    const int key0 = t * 64;
    if (FOX && !wdone && t < nt_w && key0 + 63 < lim_min) {
      const float cl = sC[63];
      const bool ok = (bound - cl < m_i - 64.f);
      if (__builtin_amdgcn_ballot_w64(ok) == ~0ull) wdone = true;
    }
    if (t < nt_w && !wdone) {
      f32x16 sacc[2];
#pragma unroll
      for (int i = 0; i < 2; i++)
#pragma unroll
        for (int r = 0; r < 16; r++) sacc[i][r] = 0.f;
#pragma unroll
      for (int ks = 0; ks < NKS; ks++) {
#pragma unroll
        for (int mb = 0; mb < 2; mb++) {
          bf16x8 kf = *(const bf16x8*)&sK[(mb * 32 + l31) * KS + ks * 16 + hh * 8];
          sacc[mb] = __builtin_amdgcn_mfma_f32_32x32x16_bf16(kf, qf[ks], sacc[mb], 0, 0, 0);
        }
      }
      const bool need_mask = (key0 + 63 > lim_min);
      float mx = -1e30f;
      if (FOX) {
#pragma unroll
        for (int mb = 0; mb < 2; mb++)
#pragma unroll
          for (int g = 0; g < 4; g++) {
            const float4 cj = *(const float4*)&sC[mb * 32 + 8 * g + 4 * hh];
            sacc[mb][4 * g + 0] = fmaf(sacc[mb][4 * g + 0], sc, ci - cj.x);
            sacc[mb][4 * g + 1] = fmaf(sacc[mb][4 * g + 1], sc, ci - cj.y);
            sacc[mb][4 * g + 2] = fmaf(sacc[mb][4 * g + 2], sc, ci - cj.z);
            sacc[mb][4 * g + 3] = fmaf(sacc[mb][4 * g + 3], sc, ci - cj.w);
          }
      }
      if (need_mask) {
#pragma unroll
        for (int mb = 0; mb < 2; mb++)
#pragma unroll
          for (int r = 0; r < 16; r++) {
            int key = key0 + mb * 32 + (r & 3) + 8 * (r >> 2) + 4 * hh;
            if (key > lim) sacc[mb][r] = -1e30f;
          }
      }
#pragma unroll
      for (int mb = 0; mb < 2; mb++)
#pragma unroll
        for (int r = 0; r < 16; r += 2) mx = fmaxf(mx, fmaxf(sacc[mb][r], sacc[mb][r + 1]));
      mx = fmaxf(mx, __shfl_xor(mx, 32));
      if (!FOX) mx *= sc;
      const float m_new = fmaxf(m_i, mx);
      const float alpha = fast_exp2(m_i - m_new);
      const bool grew = m_new > m_i;
      m_i = m_new;
      float ps = 0.f;
#pragma unroll
      for (int mb = 0; mb < 2; mb++)
#pragma unroll
        for (int r = 0; r < 16; r++) {
          float pv = FOX ? fast_exp2(sacc[mb][r] - m_new) : fast_exp2(fmaf(sacc[mb][r], sc, -m_new));
          sacc[mb][r] = pv;
          ps += pv;
        }
      l_i = l_i * alpha + ps;
      if (__builtin_amdgcn_ballot_w64(grew) != 0ull) {
#pragma unroll
        for (int db = 0; db < 2; db++)
#pragma unroll
          for (int r = 0; r < 16; r++) oacc[db][r] *= alpha;
      }
#pragma unroll
      for (int mb = 0; mb < 2; mb++)
#pragma unroll
        for (int s = 0; s < 2; s++) {
          union { unsigned u[4]; bf16x8 v; } pf;
#pragma unroll
          for (int j = 0; j < 4; j++) pf.u[j] = pack2(sacc[mb][8 * s + 2 * j], sacc[mb][8 * s + 2 * j + 1]);
#pragma unroll
          for (int db = 0; db < 2; db++) {
            const u16* vp = &sV[(db * 32 + l31) * VS + mb * 32 + s * 16 + 4 * hh];
            uint2 lo = *(const uint2*)vp, hi = *(const uint2*)(vp + 8);
            union { unsigned u[4]; bf16x8 v; } vf;
            vf.u[0] = lo.x; vf.u[1] = lo.y; vf.u[2] = hi.x; vf.u[3] = hi.y;
            oacc[db] = __builtin_amdgcn_mfma_f32_32x32x16_bf16(vf.v, pf.v, oacc[db], 0, 0, 0);
          }
        }
    }
    if (FOX && lane == 0) sFlag[((it + 1) & 1) * 4 + w] = wdone ? 1 : 0;
  }
  l_i += __shfl_xor(l_i, 32);
  if (wvalid) {
    const float inv = 1.f / l_i;
    float* op = O + (size_t)qtok * 512 + h * 64;
#pragma unroll
    for (int db = 0; db < 2; db++)
#pragma unroll
      for (int g = 0; g < 4; g++) {
        float4 o = {oacc[db][4 * g] * inv, oacc[db][4 * g + 1] * inv, oacc[db][4 * g + 2] * inv,
                    oacc[db][4 * g + 3] * inv};
        *(float4*)(op + db * 32 + 8 * g + 4 * hh) = o;
      }
  }
  __syncthreads();
}

__device__ void phase_attn(const P& p, char* smem) {
  unsigned* ctr = (unsigned*)(p.ws + OFF_CTR);
  int* sItem = (int*)(smem + 73728 - 16);
  for (;;) {
    if (threadIdx.x == 0) *sItem = (int)atomicAdd(ctr, 1u);
    __syncthreads();
    const int idx = *sItem;
    __syncthreads();
    if (idx >= 4608) break;
    int type, seq, h, qb;
    if (idx < 3008) {
      qb = 63 - (idx >> 6);
      int sub = idx & 63;
      type = sub >> 5; seq = (sub >> 3) & 3; h = sub & 7;
    } else if (idx < 3520) {
      int j = idx - 3008;
      type = j >> 8; seq = 4 + ((j >> 3) & 31); h = j & 7; qb = 0;
    } else {
      int j = idx - 3520;
      qb = 16 - (j >> 6);
      int sub = j & 63;
      type = sub >> 5; seq = (sub >> 3) & 3; h = sub & 7;
    }
    if (type == 0) attn_item<96, false>(p, seq, h, qb, smem);
    else attn_item<64, true>(p, seq, h, qb, smem);
  }
}

__device__ void phase_r3(const P& p) {
  const int lane = threadIdx.x & 63, w = threadIdx.x >> 6;
  u16* cat = (u16*)(p.ws + OFF_ACT1);
  for (int r = blockIdx.x * 4 + w; r < T_ALL; r += gridDim.x * 4) {
#pragma unroll
    for (int part = 0; part < 2; part++) {
      const float* o = p.out + (size_t)part * T_ALL * 512 + (size_t)r * 512;
      const float* g = part ? p.g_mla_out : p.g_fox_out;
      float4 a = *(const float4*)(o + lane * 4), b = *(const float4*)(o + 256 + lane * 4);
      float ss = a.x * a.x + a.y * a.y + a.z * a.z + a.w * a.w + b.x * b.x + b.y * b.y + b.z * b.z + b.w * b.w;
      ss = wave_sum(ss);
      float rs = rsqrtf(ss * (1.f / 512.f) + EPSN);
      float4 ga = *(const float4*)(g + lane * 4), gb = *(const float4*)(g + 256 + lane * 4);
      uint2 oa = {pack2(a.x * rs * ga.x, a.y * rs * ga.y), pack2(a.z * rs * ga.z, a.w * rs * ga.w)};
      uint2 ob = {pack2(b.x * rs * gb.x, b.y * rs * gb.y), pack2(b.z * rs * gb.z, b.w * rs * gb.w)};
      *(uint2*)(cat + (size_t)r * 1024 + part * 512 + lane * 4) = oa;
      *(uint2*)(cat + (size_t)r * 1024 + part * 512 + 256 + lane * 4) = ob;
    }
  }
}

template <int MODE>
__device__ void phase_rn(const P& p) {
  const int lane = threadIdx.x & 63, w = threadIdx.x >> 6;
  char* ws = p.ws;
  const float* src = (const float*)(ws + (MODE == 1 ? OFF_D : OFF_MIX));
  const float* g1 = MODE == 0 ? p.g_post_mix : (MODE == 1 ? p.g_post_mlp : p.g_ple_post);
  const float* g2 = MODE == 0 ? p.g_pre_mlp : p.g_ple;
  u16* nxt = (u16*)(ws + OFF_ACT1);
  u16* pl = (u16*)(ws + OFF_PL);
  for (int r = blockIdx.x * 4 + w; r < T_ALL; r += gridDim.x * 4) {
    const float* s = src + (size_t)r * 1024;
    float* hy = p.out + (size_t)r * 1024;
    const float* base = MODE == 0 ? (r < T_P ? p.x_p + (size_t)r * 1024 : p.x_s + (size_t)(r - T_P) * 1024) : hy;
    float4 v[4];
    float ss = 0.f;
#pragma unroll
    for (int i = 0; i < 4; i++) {
      v[i] = *(const float4*)(s + i * 256 + lane * 4);
      ss += v[i].x * v[i].x + v[i].y * v[i].y + v[i].z * v[i].z + v[i].w * v[i].w;
    }
    ss = wave_sum(ss);
    float rs = rsqrtf(ss * (1.f / 1024.f) + EPSN);
    float ss2 = 0.f;
#pragma unroll
    for (int i = 0; i < 4; i++) {
      float4 g = *(const float4*)(g1 + i * 256 + lane * 4);
      float4 b = *(const float4*)(base + i * 256 + lane * 4);
      v[i].x = b.x + v[i].x * rs * g.x;
      v[i].y = b.y + v[i].y * rs * g.y;
      v[i].z = b.z + v[i].z * rs * g.z;
      v[i].w = b.w + v[i].w * rs * g.w;
      ss2 += v[i].x * v[i].x + v[i].y * v[i].y + v[i].z * v[i].z + v[i].w * v[i].w;
      *(float4*)(hy + i * 256 + lane * 4) = v[i];
    }
    if (MODE != 2) {
      ss2 = wave_sum(ss2);
      float rs2 = rsqrtf(ss2 * (1.f / 1024.f) + EPSN);
#pragma unroll
      for (int i = 0; i < 4; i++) {
        float4 g = *(const float4*)(g2 + i * 256 + lane * 4);
        uint2 o = {pack2(v[i].x * rs2 * g.x, v[i].y * rs2 * g.y), pack2(v[i].z * rs2 * g.z, v[i].w * rs2 * g.w)};
        *(uint2*)(nxt + (size_t)r * 1024 + i * 256 + lane * 4) = o;
      }
    }
    if (MODE == 1) {
      const float* pp = r < T_P ? p.p_p + (size_t)r * 256 : p.p_s + (size_t)(r - T_P) * 256;
      float4 a = *(const float4*)(pp + lane * 4);
      uint2 o = {pack2(a.x, a.y), pack2(a.z, a.w)};
      *(uint2*)(pl + (size_t)r * 256 + lane * 4) = o;
    }
  }
}

#define NPHASE 13
__global__ void __launch_bounds__(256, 2) mega(P p, int ph_lo, int ph_hi) {
  __shared__ __attribute__((aligned(16))) char smem[73728];
  cg::grid_group grid = cg::this_grid();
  char* ws = p.ws;
  __shared__ uint4 xb_words;
  if (threadIdx.x == 0) xb_words = make_uint4(0u, 0u, 0u, 0u);
  __syncthreads();
  XcdBarrier xb = xcd_barrier_post((unsigned*)(ws + OFF_BAR), (volatile LAS unsigned*)&xb_words);
  if (ph_lo <= 0 && 0 < ph_hi) {
    for (int rep_ = 0; rep_ < 1 + ((REPEAT >> 0) & 1); rep_++) {
 phase0(p, smem);
    }
    if (0 + 1 < ph_hi) { if (0 == 0) grid.sync(); else xcd_barrier(xb); }
  }
  if (ph_lo <= 1 && 1 < ph_hi) {
    for (int rep_ = 0; rep_ < 1 + ((REPEAT >> 1) & 1); rep_++) {
        for (int t = blockIdx.x; t < 264 * 18; t += gridDim.x)
          gemm_tile<EPI_IN>(p, (const u16*)(ws + OFF_ACT1), 1024, (const u16*)(ws + OFF_WIN), 1024, (t / 18) * 128,
                            (t % 18) * 128, nullptr, 0, smem);
    }
    if (1 + 1 < ph_hi) { if (1 == 0) grid.sync(); else xcd_barrier(xb); }
  }
  if (ph_lo <= 2 && 2 < ph_hi) {
    for (int rep_ = 0; rep_ < 1 + ((REPEAT >> 2) & 1); rep_++) {
 phase_r2(p);
    }
    if (2 + 1 < ph_hi) { if (2 == 0) grid.sync(); else xcd_barrier(xb); }
  }
  if (ph_lo <= 3 && 3 < ph_hi) {
    for (int rep_ = 0; rep_ < 1 + ((REPEAT >> 3) & 1); rep_++) {
 {
        for (int t = blockIdx.x; t < 36 + 1584 + 6208; t += gridDim.x) {
          if (t < 36) scan_seq(p, t, smem);
          else if (t < 36 + 1584) {
            int j = t - 36;
            gemm_tile<EPI_BF16>(p, (const u16*)p.out, 384, (const u16*)(ws + OFF_WQ), 384, (j / 6) * 128,
                                (j % 6) * 128, ws + OFF_ACT1, 768, smem);
          } else {
            int j = t - 36 - 1584;
            gemm_tile<EPI_KV>(p, (const u16*)((char*)p.out + (size_t)T_ALL * 384 * 2), 256,
                              (const u16*)(ws + OFF_WKV), 256, (j >> 3) * 128, (j & 7) * 128, nullptr, 0, smem);
          }
        }
      }
    }
    if (3 + 1 < ph_hi) { if (3 == 0) grid.sync(); else xcd_barrier(xb); }
  }
  if (ph_lo <= 4 && 4 < ph_hi) {
    for (int rep_ = 0; rep_ < 1 + ((REPEAT >> 4) & 1); rep_++) {
 phase_attn(p, smem);
    }
    if (4 + 1 < ph_hi) { if (4 == 0) grid.sync(); else xcd_barrier(xb); }
  }
  if (ph_lo <= 5 && 5 < ph_hi) {
    for (int rep_ = 0; rep_ < 1 + ((REPEAT >> 5) & 1); rep_++) {
 phase_r3(p);
    }
    if (5 + 1 < ph_hi) { if (5 == 0) grid.sync(); else xcd_barrier(xb); }
  }
  if (ph_lo <= 6 && 6 < ph_hi) {
    for (int rep_ = 0; rep_ < 1 + ((REPEAT >> 6) & 1); rep_++) {

        for (int t = blockIdx.x; t < 264 * 8; t += gridDim.x)
          gemm_tile<EPI_F32>(p, (const u16*)(ws + OFF_ACT1), 1024, (const u16*)(ws + OFF_WO), 1024, (t >> 3) * 128,
                             (t & 7) * 128, ws + OFF_MIX, 1024, smem);
    }
    if (6 + 1 < ph_hi) { if (6 == 0) grid.sync(); else xcd_barrier(xb); }
  }
  if (ph_lo <= 7 && 7 < ph_hi) {
    for (int rep_ = 0; rep_ < 1 + ((REPEAT >> 7) & 1); rep_++) {
 phase_rn<0>(p);
    }
    if (7 + 1 < ph_hi) { if (7 == 0) grid.sync(); else xcd_barrier(xb); }
  }
  if (ph_lo <= 8 && 8 < ph_hi) {
    for (int rep_ = 0; rep_ < 1 + ((REPEAT >> 8) & 1); rep_++) {

        for (int t = blockIdx.x; t < 264 * 32; t += gridDim.x)
          gemm_tile<EPI_RELU2>(p, (const u16*)(ws + OFF_ACT1), 1024, (const u16*)(ws + OFF_WUP), 1024,
                               (t >> 5) * 128, (t & 31) * 128, ws + OFF_ACT, 4096, smem);
    }
    if (8 + 1 < ph_hi) { if (8 == 0) grid.sync(); else xcd_barrier(xb); }
  }
  if (ph_lo <= 9 && 9 < ph_hi) {
    for (int rep_ = 0; rep_ < 1 + ((REPEAT >> 9) & 1); rep_++) {

        for (int t = blockIdx.x; t < 264 * 8; t += gridDim.x)
          gemm_tile<EPI_F32>(p, (const u16*)(ws + OFF_ACT), 4096, (const u16*)(ws + OFF_WDN), 4096, (t >> 3) * 128,
                             (t & 7) * 128, ws + OFF_D, 1024, smem);
    }
    if (9 + 1 < ph_hi) { if (9 == 0) grid.sync(); else xcd_barrier(xb); }
  }
  if (ph_lo <= 10 && 10 < ph_hi) {
    for (int rep_ = 0; rep_ < 1 + ((REPEAT >> 10) & 1); rep_++) {
 phase_rn<1>(p);
    }
    if (10 + 1 < ph_hi) { if (10 == 0) grid.sync(); else xcd_barrier(xb); }
  }
  if (ph_lo <= 11 && 11 < ph_hi) {
    for (int rep_ = 0; rep_ < 1 + ((REPEAT >> 11) & 1); rep_++) {

        for (int t = blockIdx.x; t < 264 * 8; t += gridDim.x) {
          gemm_tile<EPI_GATE>(p, (const u16*)(ws + OFF_ACT1), 1024, (const u16*)(ws + OFF_WG), 1024, (t >> 3) * 128,
                              (t & 7) * 128, ws + OFF_MIX, 1024, smem);
          gemm_tile<EPI_PROD>(p, (const u16*)(ws + OFF_PL), 256, (const u16*)(ws + OFF_WPJ), 256, (t >> 3) * 128,
                              (t & 7) * 128, ws + OFF_MIX, 1024, smem);
        }
    }
    if (11 + 1 < ph_hi) { if (11 == 0) grid.sync(); else xcd_barrier(xb); }
  }
  if (ph_lo <= 12 && 12 < ph_hi) {
    for (int rep_ = 0; rep_ < 1 + ((REPEAT >> 12) & 1); rep_++) {
 phase_rn<2>(p);
    }
    if (12 + 1 < ph_hi) { if (12 == 0) grid.sync(); else xcd_barrier(xb); }
  }
}

extern "C" void kernel_launch(void* const* d_in, const int* in_sizes, int n_in, void* d_out, int out_size,
                              void* d_ws, size_t ws_size, hipStream_t stream) {
  static int grid_blocks = 0;
  if (!grid_blocks) {
    int dev = 0, cus = 0, per_cu = 0;
    hipGetDevice(&dev);
    hipDeviceGetAttribute(&cus, hipDeviceAttributeMultiprocessorCount, dev);
    hipOccupancyMaxActiveBlocksPerMultiprocessor(&per_cu, mega, 256, 0);
    if (per_cu < 1) per_cu = 1;
    if (per_cu > 2) per_cu = 2;
    grid_blocks = cus * per_cu;
  }
  if (ws_size < OFF_END + 65536) {
    fprintf(stderr, "workspace too small: %zu < %zu\n", ws_size, (size_t)OFF_END);
    return;
  }
  P p{};
  const float** f = (const float**)&p;
  for (int i = 0; i < 28; i++) f[i] = (const float*)d_in[i];
  p.out = (float*)d_out;
  p.ws = (char*)d_ws;
  hipMemsetAsync((char*)d_ws + OFF_BAR, 0, SZ_SYNC, stream);
#if COOP
  int lo = 0, hi = NPHASE;
  void* args[] = {&p, &lo, &hi};
  hipError_t e = hipLaunchCooperativeKernel((void*)mega, dim3(grid_blocks), dim3(256), args, 0, stream);
  if (e != hipSuccess) fprintf(stderr, "cooperative launch failed: %s (grid %d)\n", hipGetErrorString(e), grid_blocks);
#else
  for (int ph = 0; ph < NPHASE; ph++) mega<<<grid_blocks, 256, 0, stream>>>(p, ph, ph + 1);
#endif
}
```
